# Optimizing an MI355X kernel written in HIP

```python
import math
import jax, jax.numpy as jnp
from jax import lax
import numpy as np

D_MODEL = 1024
BATCH = 16
SEQ = 2048
DEPTH = 1

CHUNK = 64
LEFT_CHUNKS = 8
BAND = LEFT_CHUNKS + 1
ATTN_HEADS = 8
HEAD_DIM = 64
D_ATTN = ATTN_HEADS * HEAD_DIM
MAX_REL = 256
REL_FUTURE = CHUNK - 1
N_REL = REL_FUTURE + MAX_REL + 1
D_SSM = D_MODEL // 2
SSM_GROUP = 16
SSM_GROUPS = D_SSM // SSM_GROUP
SSM_STATE = 64
STEP_MIN = 0.001
STEP_MAX = 0.1
N_BRANCH = 2
D_IN = 3 * D_ATTN + D_SSM + N_BRANCH * D_MODEL
N_GROUPS = 4
EXPERTS_PER_GROUP = 4
N_EXPERTS = N_GROUPS * EXPERTS_PER_GROUP
TOP_K = 2
D_EXPERT = D_MODEL // 4
EPS = 1e-6
NEG_INF = -1e30

kernel_name = 'hybrid_chunk_attn_s5_hmoe'


def rms_norm(x, gain):
    xf = x.astype(jnp.float32)
    y = xf * lax.rsqrt(jnp.mean(xf * xf, axis=-1, keepdims=True) + EPS)
    return (y * gain.astype(jnp.float32)).astype(x.dtype)


def chunked_relpos_attention(q, k, v, q_gain, k_gain, rel_bias):
    b, l = q.shape[0], q.shape[1]
    nc = l // CHUNK
    q = rms_norm(q, q_gain)
    k = rms_norm(k, k_gain)
    pad = ((0, 0), (LEFT_CHUNKS * CHUNK, 0), (0, 0), (0, 0))
    kp = jnp.pad(k, pad).reshape(b, nc + LEFT_CHUNKS, CHUNK, ATTN_HEADS, HEAD_DIM)
    vp = jnp.pad(v, pad).reshape(b, nc + LEFT_CHUNKS, CHUNK, ATTN_HEADS, HEAD_DIM)
    band = jnp.arange(nc)[:, None] + jnp.arange(BAND)[None, :]
    kb = kp[:, band].reshape(b, nc, BAND * CHUNK, ATTN_HEADS, HEAD_DIM)
    vb = vp[:, band].reshape(b, nc, BAND * CHUNK, ATTN_HEADS, HEAD_DIM)
    qc = q.reshape(b, nc, CHUNK, ATTN_HEADS, HEAD_DIM)
    s = jnp.einsum('bnqhd,bnkhd->bhnqk', qc, kb).astype(jnp.float32) * (HEAD_DIM ** -0.5)
    q_off = jnp.arange(CHUNK)[:, None] + LEFT_CHUNKS * CHUNK
    k_off = jnp.arange(BAND * CHUNK)[None, :]
    rel_idx = jnp.clip(q_off - k_off, -REL_FUTURE, MAX_REL) + REL_FUTURE
    bias = rel_bias.astype(jnp.float32)[:, rel_idx]
    key_pos = (jnp.arange(nc)[:, None] - LEFT_CHUNKS) * CHUNK + k_off
    valid = key_pos >= 0
    s = jnp.where(valid[None, None, :, None, :], s + bias[None, :, None], NEG_INF)
    p = jax.nn.softmax(s, axis=-1).astype(v.dtype)
    o = jnp.einsum('bhnqk,bnkhd->bnqhd', p, vb)
    return o.reshape(b, l, D_ATTN)


def _complex_linear_combine(e1, e2):
    a1r, a1i, b1r, b1i = e1
    a2r, a2i, b2r, b2i = e2
    ar = a2r * a1r - a2i * a1i
    ai = a2r * a1i + a2i * a1r
    br = a2r * b1r - a2i * b1i + b2r
    bi = a2r * b1i + a2i * b1r + b2i
    return (ar, ai, br, bi)


def s5_ssm_glu(u, lambda_re, lambda_im, log_step, b_re, b_im, c_re, c_im, d_skip, w_glu, b_glu):
    bsz, l = u.shape[0], u.shape[1]
    uf = u.astype(jnp.float32).reshape(bsz, l, SSM_GROUPS, SSM_GROUP)
    lre = lambda_re.astype(jnp.float32)
    lim = lambda_im.astype(jnp.float32)
    step = jnp.exp(log_step.astype(jnp.float32))[:, None]
    mag = jnp.exp(lre * step)
    ang = lim * step
    a_re = mag * jnp.cos(ang)
    a_im = mag * jnp.sin(ang)
    num_re = a_re - 1.0
    num_im = a_im
    den = lre * lre + lim * lim
    f_re = (num_re * lre + num_im * lim) / den
    f_im = (num_im * lre - num_re * lim) / den
    br = b_re.astype(jnp.float32)
    bi = b_im.astype(jnp.float32)
    bb_re = f_re[..., None] * br - f_im[..., None] * bi
    bb_im = f_re[..., None] * bi + f_im[..., None] * br
    bu_re = jnp.einsum('blgc,gpc->blgp', uf, bb_re)
    bu_im = jnp.einsum('blgc,gpc->blgp', uf, bb_im)
    a_re_t = jnp.broadcast_to(a_re[None, None], (1, l, SSM_GROUPS, SSM_STATE))
    a_im_t = jnp.broadcast_to(a_im[None, None], (1, l, SSM_GROUPS, SSM_STATE))
    _, _, s_re, s_im = lax.associative_scan(
        _complex_linear_combine, (a_re_t, a_im_t, bu_re, bu_im), axis=1)
    y = (jnp.einsum('blgp,gcp->blgc', s_re, c_re.astype(jnp.float32))
         - jnp.einsum('blgp,gcp->blgc', s_im, c_im.astype(jnp.float32))
         + d_skip.astype(jnp.float32).reshape(SSM_GROUPS, SSM_GROUP) * uf)
    y = y.reshape(bsz, l, D_SSM).astype(u.dtype)
    z = jax.nn.gelu(y)
    return z * jax.nn.sigmoid(z @ w_glu + b_glu)


def hierarchical_moe(h, w_group_router, group_bias, w_expert_router, expert_bias, w_e_gate, w_e_up, w_e_down):
    bsz, l, d = h.shape
    t = bsz * l
    ht = h.reshape(t, d)
    group_logits = (ht @ w_group_router).astype(jnp.float32) + group_bias.astype(jnp.float32)
    group_prob = jax.nn.softmax(group_logits, axis=-1)
    g_prob, g_idx = lax.top_k(group_prob, 1)
    expert_logits = (ht @ w_expert_router).astype(jnp.float32) + expert_bias.astype(jnp.float32)
    expert_logits = expert_logits.reshape(t, N_GROUPS, EXPERTS_PER_GROUP)
    in_group = jnp.take_along_axis(expert_logits, g_idx[:, :, None], axis=1)[:, 0]
    e_prob = jax.nn.softmax(in_group, axis=-1)
    e_val, e_loc = lax.top_k(e_prob, TOP_K)
    e_val = e_val / jnp.sum(e_val, axis=-1, keepdims=True)
    weights = g_prob * e_val
    e_glob = g_idx * EXPERTS_PER_GROUP + e_loc
    gates = jnp.sum(jax.nn.one_hot(e_glob, N_EXPERTS, dtype=jnp.float32) * weights[..., None], axis=1)
    gates = gates.astype(h.dtype)
    a = jnp.einsum('td,edf->tef', ht, w_e_gate)
    u = jnp.einsum('td,edf->tef', ht, w_e_up)
    hid = jax.nn.silu(a) * u * gates[:, :, None]
    out = hid.reshape(t, N_EXPERTS * D_EXPERT) @ w_e_down.reshape(N_EXPERTS * D_EXPERT, d)
    return out.reshape(bsz, l, d)


def setup_inputs(seed: int = 0) -> dict:
    key = jax.random.key(seed)
    ks = jax.random.split(key, 32)
    f32 = jnp.float32

    def nrm(k, shape, scale):
        return jax.random.normal(k, shape, f32) * scale

    n_idx = jnp.arange(SSM_STATE, dtype=f32)
    return {
        'x': nrm(ks[0], (BATCH, SEQ, D_MODEL), 1.0),
        'mix_norm_gain': 1.0 + nrm(ks[1], (DEPTH, D_MODEL), 0.02),
        'w_in': nrm(ks[2], (DEPTH, D_MODEL, D_IN), D_MODEL ** -0.5),
        'b_gate': nrm(ks[3], (DEPTH, N_BRANCH * D_MODEL), 0.02),
        'q_gain': 1.0 + nrm(ks[4], (DEPTH, HEAD_DIM), 0.02),
        'k_gain': 1.0 + nrm(ks[5], (DEPTH, HEAD_DIM), 0.02),
        'rel_bias': nrm(ks[6], (DEPTH, ATTN_HEADS, N_REL), 0.1),
        'ssm_lambda_re': -0.5 + nrm(ks[7], (DEPTH, SSM_GROUPS, SSM_STATE), 0.01),
        'ssm_lambda_im': math.pi * n_idx[None, None, :] + nrm(ks[8], (DEPTH, SSM_GROUPS, SSM_STATE), 0.01),
        'ssm_log_step': jax.random.uniform(ks[9], (DEPTH, SSM_GROUPS), f32, math.log(STEP_MIN), math.log(STEP_MAX)),
        'ssm_b_re': nrm(ks[10], (DEPTH, SSM_GROUPS, SSM_STATE, SSM_GROUP), (2 * SSM_GROUP) ** -0.5),
        'ssm_b_im': nrm(ks[11], (DEPTH, SSM_GROUPS, SSM_STATE, SSM_GROUP), (2 * SSM_GROUP) ** -0.5),
        'ssm_c_re': nrm(ks[12], (DEPTH, SSM_GROUPS, SSM_GROUP, SSM_STATE), (2 * SSM_STATE) ** -0.5),
        'ssm_c_im': nrm(ks[13], (DEPTH, SSM_GROUPS, SSM_GROUP, SSM_STATE), (2 * SSM_STATE) ** -0.5),
        'ssm_d': nrm(ks[14], (DEPTH, D_SSM), 1.0),
        'w_glu': nrm(ks[15], (DEPTH, D_SSM, D_SSM), D_SSM ** -0.5),
        'b_glu': nrm(ks[16], (DEPTH, D_SSM), 0.02),
        'w_branch': nrm(ks[17], (DEPTH, D_ATTN + D_SSM, D_MODEL), D_ATTN ** -0.5),
        'w_out': nrm(ks[18], (DEPTH, D_MODEL, D_MODEL), D_MODEL ** -0.5),
        'ffn_norm_gain': 1.0 + nrm(ks[19], (DEPTH, D_MODEL), 0.02),
        'w_group_router': nrm(ks[20], (DEPTH, D_MODEL, N_GROUPS), D_MODEL ** -0.5),
        'group_bias': nrm(ks[21], (DEPTH, N_GROUPS), 0.01),
        'w_expert_router': nrm(ks[22], (DEPTH, D_MODEL, N_EXPERTS), D_MODEL ** -0.5),
        'expert_bias': nrm(ks[23], (DEPTH, N_EXPERTS), 0.01),
        'w_e_gate': nrm(ks[24], (DEPTH, N_EXPERTS, D_MODEL, D_EXPERT), D_MODEL ** -0.5),
        'w_e_up': nrm(ks[25], (DEPTH, N_EXPERTS, D_MODEL, D_EXPERT), D_MODEL ** -0.5),
        'w_e_down': nrm(ks[26], (DEPTH, N_EXPERTS, D_EXPERT, D_MODEL), D_EXPERT ** -0.5),
    }


def reference(x, mix_norm_gain, w_in, b_gate, q_gain, k_gain, rel_bias,
              ssm_lambda_re, ssm_lambda_im, ssm_log_step, ssm_b_re, ssm_b_im,
              ssm_c_re, ssm_c_im, ssm_d, w_glu, b_glu, w_branch, w_out,
              ffn_norm_gain, w_group_router, group_bias, w_expert_router, expert_bias,
              w_e_gate, w_e_up, w_e_down):
    bsz, l, _ = x.shape
    for i in range(DEPTH):
        h = rms_norm(x, mix_norm_gain[i])
        proj = h @ w_in[i]
        q = proj[..., :D_ATTN].reshape(bsz, l, ATTN_HEADS, HEAD_DIM)
        k = proj[..., D_ATTN:2 * D_ATTN].reshape(bsz, l, ATTN_HEADS, HEAD_DIM)
        v = proj[..., 2 * D_ATTN:3 * D_ATTN].reshape(bsz, l, ATTN_HEADS, HEAD_DIM)
        u = proj[..., 3 * D_ATTN:3 * D_ATTN + D_SSM]
        gate = jax.nn.sigmoid(proj[..., 3 * D_ATTN + D_SSM:] + b_gate[i])
        gate = gate.reshape(bsz, l, N_BRANCH, D_MODEL)
        y_attn = chunked_relpos_attention(q, k, v, q_gain[i], k_gain[i], rel_bias[i])
        y_ssm = s5_ssm_glu(u, ssm_lambda_re[i], ssm_lambda_im[i], ssm_log_step[i],
                           ssm_b_re[i], ssm_b_im[i], ssm_c_re[i], ssm_c_im[i],
                           ssm_d[i], w_glu[i], b_glu[i])
        wb = w_branch[i]
        merged = (gate[:, :, 0] * (y_attn @ wb[:D_ATTN])
                  + gate[:, :, 1] * (y_ssm @ wb[D_ATTN:]))
        x = x + merged @ w_out[i]
        h = rms_norm(x, ffn_norm_gain[i])
        x = x + hierarchical_moe(h, w_group_router[i], group_bias[i], w_expert_router[i],
                                 expert_bias[i], w_e_gate[i], w_e_up[i], w_e_down[i])
    return x
```

```cpp
#include <hip/hip_runtime.h>
#include <cstdio>
#include <cstdint>
#include <cmath>

constexpr int DM = 1024, NB = 16, SEQ = 2048, T = NB * SEQ, CHK = 64, NCH = SEQ / CHK, NH = 8, HD = 64, DA = 512, DS = 512;
constexpr int SGC = 16, NGR = 32, NST = 64, DIN = 4096, NEX = 16, DEX = 256, NREL = 320, LEFT = 8, NCLS = 24;
constexpr float EPS = 1e-6f;
constexpr float LOG2E = 1.4426950408889634f;
constexpr float QSCALE = 0.125f * LOG2E;
constexpr int NWAVES = 8, NTHR = 512;

constexpr size_t MiB = 1u << 20;
constexpr size_t OFF_CTL = 0, CTL_ZERO_BYTES = 1 * MiB;
constexpr size_t OFF_TAB = 1 * MiB;
constexpr size_t OFF_LIST = 56 * MiB;
constexpr size_t OFF_TOKC = 59 * MiB;
constexpr size_t OFF_TOKW = OFF_TOKC + 128 * 1024;
constexpr size_t OFF_RSTD1 = OFF_TOKW + 256 * 1024;
constexpr size_t OFF_RSTD2 = OFF_RSTD1 + 128 * 1024;
constexpr size_t OFF_XB = 64 * MiB;
constexpr size_t OFF_Q = 128 * MiB, OFF_K = 160 * MiB, OFF_V = 192 * MiB, OFF_U = 224 * MiB;
constexpr size_t OFF_G = 256 * MiB;
constexpr size_t OFF_YA = 416 * MiB, OFF_Z = 448 * MiB;
constexpr size_t OFF_YS = OFF_U, OFF_MERGED = OFF_Q, OFF_HID = OFF_V;
constexpr size_t WS_END = 480 * MiB;
constexpr int CW_CNT = 1024;
constexpr int CW_BAR = 4096;
constexpr int CW_ATTQ = 3072;

constexpr int LDS_BYTES = 147456, LDSCTL_OFF = 131072, MISC_OFF = LDSCTL_OFF + 320;

#define GAS __attribute__((address_space(1)))
#define LAS __attribute__((address_space(3)))
typedef unsigned short bf16;
typedef unsigned v4u __attribute__((ext_vector_type(4)));
typedef float f32x4 __attribute__((ext_vector_type(4)));

__device__ __forceinline__ unsigned f2bf(float f) { unsigned u = __builtin_bit_cast(unsigned, f); return (u + 0x7fffu + ((u >> 16) & 1u)) >> 16; }
__device__ __forceinline__ float bf2f(unsigned b) { return __builtin_bit_cast(float, (b & 0xffffu) << 16); }
__device__ __forceinline__ float bflo(unsigned w) { return __builtin_bit_cast(float, w << 16); }
__device__ __forceinline__ float bfhi(unsigned w) { return __builtin_bit_cast(float, w & 0xffff0000u); }
__device__ __forceinline__ unsigned pk2(float lo, float hi) { return f2bf(lo) | (f2bf(hi) << 16); }
__device__ __forceinline__ float wave_sum(float v) {
#pragma unroll
    for (int o = 1; o < 64; o <<= 1) v += __shfl_xor(v, o);
    return v;
}
__device__ __forceinline__ float sigmoidf_(float x) { return 1.0f / (1.0f + __expf(-x)); }
__device__ __forceinline__ float gelu_tanh(float x) { const float u = 0.7978845608028654f * (x + 0.044715f * x * x * x); return 0.5f * x * (1.0f + tanhf(u)); }

#define XB_TMO      128
#define XB_XCNT(j)  (256  + 64 * (j))
#define XB_XSUB(j)  (1280 + 64 * (j))
#define XB_XGEN(j)  (2304 + 64 * (j))
#define XB_TOP      3328
#define XB_TOPGEN   3392
#define XCD_BAR_WORDS 3456
#define XB_SPIN_CAP (1u << 22)
__device__ __forceinline__ unsigned xb_ld(unsigned* p)              { return __hip_atomic_load(p, __ATOMIC_RELAXED, __HIP_MEMORY_SCOPE_AGENT); }
__device__ __forceinline__ unsigned xb_add(unsigned* p, unsigned v) { return __hip_atomic_fetch_add(p, v, __ATOMIC_RELAXED, __HIP_MEMORY_SCOPE_AGENT); }
__device__ __forceinline__ unsigned xb_xcc_id() { return (unsigned)__builtin_amdgcn_s_getreg((3 << 11) | 20) & 0xFu; }
#define XB_SPIN(cond, bar) do { unsigned _sp = 0; while (cond) { __builtin_amdgcn_s_sleep(1); \
    if ((++_sp & 255u) == 0u) { if (xb_ld(&(bar)[XB_TMO])) break; if (_sp > XB_SPIN_CAP) { atomicAdd(&(bar)[XB_TMO], 1u); break; } } } } while (0)
struct XcdBarrier { unsigned* bar; unsigned x; volatile LAS unsigned* st; };
__device__ __forceinline__ XcdBarrier xcd_barrier_post(unsigned* bar, volatile LAS unsigned* st) {
    XcdBarrier b; b.bar = bar; b.x = xb_xcc_id(); b.st = st;
    if (threadIdx.x == 0) (void)xb_add(&bar[XB_XCNT(b.x)], 1u);
    return b;
}
__device__ __forceinline__ void xcd_barrier_complete(unsigned* bar, unsigned x, unsigned& nloc, unsigned& nx) {
    const unsigned G = gridDim.x * gridDim.y * gridDim.z;
    unsigned sum, cnt, mine, sp = 0u;
    for (;;) {
        sum = 0u; cnt = 0u; mine = 0u;
#pragma unroll
        for (unsigned j = 0; j < 16; ++j) { const unsigned c = xb_ld(&bar[XB_XCNT(j)]); sum += c; cnt += (c > 0u) ? 1u : 0u; mine = (j == x) ? c : mine; }
        if (sum == G) break;
        __builtin_amdgcn_s_sleep(1);
        if ((++sp & 255u) == 0u) { if (xb_ld(&bar[XB_TMO])) break; if (sp > XB_SPIN_CAP) { atomicAdd(&bar[XB_TMO], 1u); break; } }
    }
    nloc = mine > 0u ? mine : 1u; nx = cnt > 0u ? cnt : 1u;
}
__device__ __forceinline__ void xcd_barrier(const XcdBarrier& b) {
    asm volatile("s_waitcnt vmcnt(0)" ::: "memory");
    __syncthreads();
    if (threadIdx.x == 0) {
        unsigned* bar = b.bar;
        __builtin_amdgcn_s_waitcnt(0);
        unsigned nloc = b.st[0], nx = b.st[1];
        if (nloc == 0u) { xcd_barrier_complete(bar, b.x, nloc, nx); b.st[0] = nloc; b.st[1] = nx; }
        const unsigned old = xb_add(&bar[XB_XSUB(b.x)], 1u);
        const unsigned gen = old / nloc;
        if (old + 1u == (gen + 1u) * nloc) {
            __builtin_amdgcn_fence(__ATOMIC_RELEASE, "agent");
            asm volatile("s_waitcnt vmcnt(0)" ::: "memory");
            const unsigned og = xb_add(&bar[XB_TOP], 1u);
            const unsigned tg = og / nx;
            if (og + 1u == (tg + 1u) * nx) xb_add(&bar[XB_TOPGEN], 1u);
            else XB_SPIN(xb_ld(&bar[XB_TOPGEN]) == tg, bar);
            __builtin_amdgcn_fence(__ATOMIC_ACQUIRE, "agent");
            xb_add(&bar[XB_XGEN(b.x)], 1u);
            asm volatile("s_waitcnt vmcnt(0)" ::: "memory");
        } else {
            __builtin_amdgcn_fence(__ATOMIC_ACQUIRE, "agent");
            XB_SPIN(xb_ld(&bar[XB_XGEN(b.x)]) == gen, bar);
            asm volatile("s_waitcnt vmcnt(0)" ::: "memory");
        }
    }
    __syncthreads();
}

struct Args { const float* in[27]; float* out; unsigned char* ws; int ph_lo, ph_hi; };
struct Frame {
    unsigned char* lds; int tid, lane, wave, vcu, G;
    const float* x; const float* gain1; const float* w_in; const float* b_gate; const float* q_gain; const float* k_gain; const float* rel_bias;
    const float *lam_re, *lam_im, *log_step, *sb_re, *sb_im, *sc_re, *sc_im, *ssm_d, *w_glu, *b_glu, *w_branch, *w_out, *gain2, *w_gr, *b_gr, *w_er, *b_er, *w_eg, *w_eu, *w_ed;
    float* out; unsigned* ctl;
    bf16 *XB, *Q, *K, *V, *U, *GT, *YA, *Z, *YS, *MG, *HID;
    int* LIST; int* TOKC; float* TOKW; float* RSTD1; float* RSTD2;
};

__device__ __forceinline__ float dpp_sum16(float v) {
    v += __builtin_bit_cast(float, __builtin_amdgcn_mov_dpp(__builtin_bit_cast(int, v), 0xB1, 0xF, 0xF, true));
    v += __builtin_bit_cast(float, __builtin_amdgcn_mov_dpp(__builtin_bit_cast(int, v), 0x4E, 0xF, 0xF, true));
    v += __builtin_bit_cast(float, __builtin_amdgcn_mov_dpp(__builtin_bit_cast(int, v), 0x141, 0xF, 0xF, true));
    v += __builtin_bit_cast(float, __builtin_amdgcn_mov_dpp(__builtin_bit_cast(int, v), 0x140, 0xF, 0xF, true));
    return v;
}
__device__ __forceinline__ void ph_xconv(Frame& F, int nwv) {
    const int gw = F.vcu * nwv + F.wave, NGW = F.G * nwv, lr = F.lane & 15, rsub = F.lane >> 4;
    f32x4 a[8], b[8];
    int m4 = gw;
    if (m4 < T / 4) { const f32x4* xr = (const f32x4*)(F.x + (size_t)(m4 * 4 + rsub) * DM + 8 * lr);
#pragma unroll
        for (int j = 0; j < 8; ++j) { a[j] = __builtin_nontemporal_load(xr + 32 * j); b[j] = __builtin_nontemporal_load(xr + 32 * j + 1); } }
    for (; m4 < T / 4; m4 += NGW) {
        const int m = m4 * 4 + rsub, mn4 = m4 + NGW;
        f32x4 a2[8], b2[8];
        if (mn4 < T / 4) { const f32x4* xr = (const f32x4*)(F.x + (size_t)(mn4 * 4 + rsub) * DM + 8 * lr);
#pragma unroll
            for (int j = 0; j < 8; ++j) { a2[j] = __builtin_nontemporal_load(xr + 32 * j); b2[j] = __builtin_nontemporal_load(xr + 32 * j + 1); } }
        float s = 0.f;
#pragma unroll
        for (int j = 0; j < 8; ++j) s += ((a[j].x * a[j].x + a[j].y * a[j].y) + (a[j].z * a[j].z + a[j].w * a[j].w)) + ((b[j].x * b[j].x + b[j].y * b[j].y) + (b[j].z * b[j].z + b[j].w * b[j].w));
        s = dpp_sum16(s);
        if (lr == 0) F.RSTD1[m] = 1.0f / sqrtf(s * (1.0f / DM) + EPS);
        v4u* o = (v4u*)(F.XB + (size_t)m * DM + 8 * lr);
#pragma unroll
        for (int j = 0; j < 8; ++j) o[16 * j] = (v4u){pk2(a[j].x, a[j].y), pk2(a[j].z, a[j].w), pk2(b[j].x, b[j].y), pk2(b[j].z, b[j].w)};
        if (mn4 < T / 4) {
#pragma unroll
            for (int j = 0; j < 8; ++j) { a[j] = a2[j]; b[j] = b2[j]; } }
    }
}

__device__ __forceinline__ int pair_index(int lo, int hi) { return lo == 0 ? hi - 1 : (lo == 1 ? hi + 1 : 5); }
__device__ __forceinline__ void pair_decode(int pr, int& lo, int& hi) { lo = pr < 3 ? 0 : (pr < 5 ? 1 : 2); hi = pr < 3 ? pr + 1 : (pr < 5 ? pr - 1 : 3); }
namespace pg {
typedef short bf16x8 __attribute__((ext_vector_type(8)));
typedef unsigned u32x4 __attribute__((ext_vector_type(4)));
typedef unsigned u32x2 __attribute__((ext_vector_type(2)));
typedef float f32x2 __attribute__((ext_vector_type(2)));
constexpr int BM = 256, BK = 64, HALF = 128, HTB = HALF * BK * 2, STAGE_BYTES = 8 * HTB, NXCD = 8, WGM = 8;
__host__ __device__ __forceinline__ int lds_byte(int r, int c) { const int st = (r >> 4) * 2 + (c >> 5), rr = r & 15, cc = c & 31, ob = rr * 64 + cc * 2; return st * 1024 + (ob ^ (((ob >> 9) & 1) << 5)); }
__host__ __device__ __forceinline__ void stage_rc(int b, int& R, int& C) { const int st = b / 1024, sb = b % 1024, swz = sb ^ (((sb >> 9) & 1) << 5); R = (st >> 1) * 16 + swz / 64; C = (st & 1) * 32 + (swz % 64) / 2; }
__host__ __device__ __forceinline__ int perm32(int rho) { const int n = rho >> 4, i = rho & 15; return 8 * (i >> 2) + 4 * n + (i & 3); }
typedef __bf16 bf16x2_t __attribute__((ext_vector_type(2)));
__device__ __forceinline__ unsigned cvt_pk_bf16(float lo, float hi) { f32x2 v = {lo, hi}; bf16x2_t b = __builtin_convertvector(v, bf16x2_t); return __builtin_bit_cast(unsigned, b); }

enum { UF_FIRST = 1, UF_LAST = 2 };
struct Unit { const char* A; const char* B; const int* list; int pm, pn, flags, cnt, aux; };

struct TileOrder {
    int nM, nN, nwg, G, c;
    __device__ __forceinline__ void init(int M, int N, int G_, int c_) { nM = M / BM; nN = N / BM; nwg = nM * nN; G = G_; c = c_; }
    __device__ __forceinline__ bool tile(int i, int& pm, int& pn) const {
        const long L = (long)i * G + c; if (L >= nwg) return false;
        int wgid = (int)L; { const int q = nwg / NXCD, r = nwg % NXCD, xcd = wgid % NXCD, off = wgid / NXCD; wgid = (xcd < r ? xcd * (q + 1) : r * (q + 1) + (xcd - r) * q) + off; }
        const int nig = WGM * nN, gid = wgid / nig, fm = gid * WGM, gsz = (nM - fm) < WGM ? (nM - fm) : WGM;
        pm = fm + ((wgid % nig) % gsz); pn = (wgid % nig) / gsz; return true;
    }
};

typedef f32x4 Acc[2][2][4][2];
template <class Epi, class Sched, bool GATHER, bool BSPLIT = false>
__device__ __forceinline__ void gemm_phase(LAS unsigned char* lds, const int K, const int lda_b, const int ldb_b, const Sched& S, const Epi& E) {
    const int tid = threadIdx.x, wid = __builtin_amdgcn_readfirstlane(tid >> 6), lane = tid & 63, wr = wid >> 2, wc = wid & 3, fr = lane & 15, fq = lane >> 4;
    const int nt = K / BK;
    unsigned voffB[2], oA[2][2], noA[2][2]; int RA[2], CA[2];
#pragma unroll
    for (int i = 0; i < 2; ++i) { int R, C; stage_rc(tid * 16 + i * 8192, R, C); const int Rb = Epi::PERM ? ((R & ~31) + perm32(R & 31)) : R;
        RA[i] = R; CA[i] = C; voffB[i] = (unsigned)(Rb * ldb_b + C * 2);
        oA[0][i] = (unsigned)(R * lda_b + C * 2); oA[1][i] = (unsigned)((R + HALF) * lda_b + C * 2); noA[0][i] = oA[0][i]; noA[1][i] = oA[1][i]; }
    const size_t kstep = (size_t)(BK * 2);
    const size_t hstepB = (size_t)HALF * ldb_b;
    const unsigned ldsw = (unsigned)wid * 1024u;
    const int aoff = lds_byte(wr * 64 + fr, fq * 8), boff = lds_byte(wc * 32 + fr, fq * 8);
#define PG_SA(b, h) (((b) * 2 + (h)) * HTB)
#define PG_SB(b, h) ((4 + (b) * 2 + (h)) * HTB)
#define PG_STAGE_B(bufoff, gbase) do { _Pragma("unroll") for (int _i = 0; _i < 2; ++_i) \
        __builtin_amdgcn_global_load_lds((const unsigned*)((const char*)(gbase) + voffB[_i]), (LAS unsigned*)(lds + (bufoff) + ldsw + _i * 8192), 16, 0, 0); } while (0)
#define PG_STAGE_A(bufoff, gbase, o0, o1) do { \
        __builtin_amdgcn_global_load_lds((const unsigned*)((const char*)(gbase) + (o0)), (LAS unsigned*)(lds + (bufoff) + ldsw), 16, 0, 0); \
        __builtin_amdgcn_global_load_lds((const unsigned*)((const char*)(gbase) + (o1)), (LAS unsigned*)(lds + (bufoff) + ldsw + 8192), 16, 0, 0); } while (0)
#define PG_LDA(dst, b, h) do { _Pragma("unroll") for (int m = 0; m < 4; ++m) _Pragma("unroll") for (int k = 0; k < 2; ++k) dst[m][k] = *(const LAS bf16x8*)(lds + PG_SA(b, h) + aoff + m * 2048 + k * 1024); } while (0)
#define PG_LDB(dst, b, h) do { _Pragma("unroll") for (int n = 0; n < 2; ++n) _Pragma("unroll") for (int k = 0; k < 2; ++k) dst[n][k] = *(const LAS bf16x8*)(lds + PG_SB(b, h) + boff + n * 2048 + k * 1024); } while (0)
#define PG_MMA(ai, bj, At, Bt) do { __builtin_amdgcn_s_setprio(1); _Pragma("unroll") for (int m = 0; m < 4; ++m) _Pragma("unroll") for (int n = 0; n < 2; ++n) _Pragma("unroll") for (int k = 0; k < 2; ++k) \
        acc[ai][bj][m][n] = __builtin_amdgcn_mfma_f32_16x16x32_bf16(Bt[n][k], At[m][k], acc[ai][bj][m][n], 0, 0, 0); __builtin_amdgcn_s_setprio(0); } while (0)
#define PG_WAIT_V(n) asm volatile("s_waitcnt vmcnt(" #n ")" ::: "memory")
#define PG_WAIT_L(n) asm volatile("s_waitcnt lgkmcnt(" #n ")" ::: "memory")
#define PG_BAR __builtin_amdgcn_s_barrier()
#define PG_SCHED __builtin_amdgcn_sched_barrier(0)
#define PG_GATHER_OFFS(dst, U) do { if constexpr (GATHER) { _Pragma("unroll") for (int _h = 0; _h < 2; ++_h) _Pragma("unroll") for (int _i = 0; _i < 2; ++_i) { \
        const int _r = _h * HALF + RA[_i]; const int _row = (U).list[_r < (U).cnt ? _r : 0]; dst[_h][_i] = (unsigned)_row * (unsigned)lda_b + (unsigned)(CA[_i] * 2); } } } while (0)
    Unit cur, nxt; int ui = 0;
    if (!S.next(0, cur)) return;
    PG_GATHER_OFFS(oA, cur);
    Acc acc;
#pragma unroll
    for (int a = 0; a < 2; ++a)
#pragma unroll
        for (int b = 0; b < 2; ++b)
#pragma unroll
            for (int m = 0; m < 4; ++m)
#pragma unroll
                for (int n = 0; n < 2; ++n) acc[a][b][m][n] = (f32x4){0.f, 0.f, 0.f, 0.f};
    bf16x8 At[4][2], B0[2][2], B1[2][2];
    const char* cA = cur.A; const char* cB = cur.B;
    PG_STAGE_B(PG_SB(0, 0), cB); PG_STAGE_B(PG_SB(0, 1), cB + hstepB); PG_STAGE_A(PG_SA(0, 0), cA, oA[0][0], oA[0][1]); PG_STAGE_A(PG_SA(0, 1), cA, oA[1][0], oA[1][1]);
    if (wr == 1) PG_BAR;
    PG_WAIT_V(2); PG_BAR;
    PG_STAGE_B(PG_SB(1, 0), cB + kstep); PG_STAGE_A(PG_SA(1, 0), cA + kstep, oA[0][0], oA[0][1]); PG_STAGE_B(PG_SB(1, 1), cB + hstepB + kstep);
    PG_WAIT_V(6); PG_BAR;
    for (;;) {
        const bool has_next = S.next(ui + 1, nxt);
        const char* nA = has_next ? nxt.A : cA; const char* nB = has_next ? nxt.B : cB;
        if constexpr (GATHER) { if (has_next) { PG_GATHER_OFFS(noA, nxt); } else {
#pragma unroll
            for (int h = 0; h < 2; ++h)
#pragma unroll
                for (int i = 0; i < 2; ++i) noA[h][i] = oA[h][i]; } }
        for (int t = 0; t < nt; t += 2) {
            const bool last = (t == nt - 2);
            const char* a1 = cA + (size_t)(t + 1) * kstep;
            const char* a2 = last ? nA : cA + (size_t)(t + 2) * kstep; const char* b2 = last ? nB : cB + (size_t)(t + 2) * kstep;
            if constexpr (BSPLIT) { if (!last && (t + 2) >= (nt >> 1)) b2 = cB + cur.aux + (size_t)(t + 2 - (nt >> 1)) * kstep; }
            const char* a3 = a2 + kstep; const char* b3 = b2 + kstep;
            unsigned q00 = oA[0][0], q01 = oA[0][1], q10 = oA[1][0], q11 = oA[1][1];
            if constexpr (GATHER) { if (last) { q00 = noA[0][0]; q01 = noA[0][1]; q10 = noA[1][0]; q11 = noA[1][1]; } }
            PG_LDB(B0, 0, 0); PG_LDB(B1, 0, 1); PG_SCHED; PG_LDA(At, 0, 0); PG_STAGE_A(PG_SA(1, 1), a1, oA[1][0], oA[1][1]);
            PG_WAIT_V(8); PG_WAIT_L(0); PG_BAR; PG_MMA(0, 0, At, B0); PG_MMA(0, 1, At, B1); PG_BAR; PG_SCHED;
            PG_LDA(At, 0, 1); PG_STAGE_B(PG_SB(0, 0), b2); PG_STAGE_B(PG_SB(0, 1), b2 + hstepB); PG_STAGE_A(PG_SA(0, 0), a2, q00, q01);
            PG_WAIT_V(8); PG_WAIT_L(0); PG_BAR; PG_MMA(1, 0, At, B0); PG_MMA(1, 1, At, B1); PG_BAR; PG_SCHED;
            PG_LDB(B0, 1, 0); PG_LDB(B1, 1, 1); PG_SCHED; PG_LDA(At, 1, 0); PG_STAGE_A(PG_SA(0, 1), a2, q10, q11);
            PG_WAIT_V(8); PG_WAIT_L(0); PG_BAR; PG_MMA(0, 0, At, B0); PG_MMA(0, 1, At, B1); PG_BAR; PG_SCHED;
            PG_LDA(At, 1, 1); PG_STAGE_B(PG_SB(1, 0), b3); PG_STAGE_B(PG_SB(1, 1), b3 + hstepB); PG_STAGE_A(PG_SA(1, 0), a3, q00, q01);
            PG_WAIT_V(8); PG_WAIT_L(0); PG_BAR; PG_MMA(1, 0, At, B0); PG_MMA(1, 1, At, B1); PG_BAR; PG_SCHED;
        }
        if (wr == 0) PG_BAR;
        if constexpr (!Epi::AFTER_DRAIN) { if (cur.flags & UF_LAST) E(acc, cur, wr, wc, fr, fq); else E.mid(acc, cur, wr, wc, fr, fq); }
        if (!has_next) break;
        if (nxt.flags & UF_FIRST) {
#pragma unroll
            for (int a = 0; a < 2; ++a)
#pragma unroll
                for (int b = 0; b < 2; ++b)
#pragma unroll
                    for (int m = 0; m < 4; ++m)
#pragma unroll
                        for (int n = 0; n < 2; ++n) acc[a][b][m][n] = (f32x4){0.f, 0.f, 0.f, 0.f};
        }
        cur = nxt; cA = nA; cB = nB; ++ui;
        if constexpr (GATHER) {
#pragma unroll
            for (int h = 0; h < 2; ++h)
#pragma unroll
                for (int i = 0; i < 2; ++i) oA[h][i] = noA[h][i]; }
        if (wr == 1) PG_BAR;
    }
    PG_WAIT_V(0);
    PG_BAR;
    if constexpr (Epi::AFTER_DRAIN) E.fused(acc, cur, wr, wc, fr, fq, lds, wid, lane);
#undef PG_SA
#undef PG_SB
#undef PG_STAGE_A
#undef PG_STAGE_B
#undef PG_LDA
#undef PG_LDB
#undef PG_MMA
#undef PG_WAIT_V
#undef PG_WAIT_L
#undef PG_BAR
#undef PG_SCHED
#undef PG_GATHER_OFFS
}
}

struct MatDesc { const float* W0; const float* W1; const float* gain; bf16* WT; int K, N, ldw, mode; };
__device__ __forceinline__ void p0_item(const MatDesc& d, float* scr, int item, int lane) {
    const int nblk = d.N / 64, kb = item / nblk, nb = item % nblk, k0 = 32 * kb, n0 = 64 * nb;
    const int c4 = lane & 15, kr = lane >> 4, n = n0 + 4 * c4;
    const float* col;
    if (d.mode == 1) { int src = n; if (n < 2 * DA) { const int seg = n >> 9, pl = (n >> 8) & 1, bj = (n >> 7) & 1, wc = (n >> 5) & 3, w = n & 31; src = seg * DA + (4 * pl + wc) * HD + 32 * bj + w; }
        else if (n >= 4 * DA) { const int np = n - 4 * DA, tile = np >> 8, c = np & 255; src = 4 * DA + (c >> 7) * DM + 128 * tile + (c & 127); }
        col = d.W0 + src; }
    else if (d.mode == 2) { const int hu = (n >> 8) * 128 + (n & 127); col = ((n >> 7) & 1) ? d.W1 + hu : d.W0 + hu; }
    else col = d.W0 + n;
    f32x4 v[8];
#pragma unroll
    for (int i = 0; i < 8; ++i) v[i] = *(const f32x4*)(col + (size_t)(k0 + 4 * i + kr) * d.ldw);
#pragma unroll
    for (int i = 0; i < 8; ++i) { const int kk = 4 * i + kr; const float g = d.gain ? d.gain[k0 + kk] : 1.0f; *(f32x4*)(scr + kk * 68 + 4 * c4) = v[i] * g; }
    asm volatile("s_waitcnt lgkmcnt(0)" ::: "memory");
    const int cq = lane & 3;
#pragma unroll
    for (int j = 0; j < 4; ++j) { const int nn = (lane >> 2) + 16 * j; const float* s = scr + (8 * cq) * 68 + nn;
        v4u o; o.x = pk2(s[0 * 68], s[1 * 68]); o.y = pk2(s[2 * 68], s[3 * 68]); o.z = pk2(s[4 * 68], s[5 * 68]); o.w = pk2(s[6 * 68], s[7 * 68]);
        *(v4u*)(d.WT + (size_t)(n0 + nn) * d.K + k0 + 8 * cq) = o; }
    asm volatile("s_waitcnt lgkmcnt(0)" ::: "memory");
}
constexpr size_t OFF_WIN = 2 * MiB, OFF_WGLU = 10 * MiB, OFF_WA = 11 * MiB, OFF_WS = 12 * MiB, OFF_WOUT = 13 * MiB, OFF_WGU = 15 * MiB, OFF_WD = 31 * MiB, OFF_WSSM = 39 * MiB;
__device__ __forceinline__ void ph_weights(Frame& F, unsigned char* ws, bool first_part, int worker, int nworkers, int wv0 = 0, int nwv = NWAVES) {
    float* scr = (float*)(F.lds + F.wave * 16384);
    const int gw = worker * nwv + (F.wave - wv0), NGW = nworkers * nwv;
    constexpr int I_IN = (DM / 32) * (DIN / 64), I_GLU = (DS / 32) * (DS / 64), I_BR = (DA / 32) * (DM / 64), I_OUT = (DM / 32) * (DM / 64), I_GU = (DM / 32) * (512 / 64), I_D = (DEX / 32) * (DM / 64);
    constexpr int NITEMS = I_IN + I_GLU + 2 * I_BR + I_OUT + NEX * I_GU + NEX * I_D;
    for (int it = (first_part ? 0 : I_IN) + gw; it < (first_part ? I_IN : NITEMS); it += NGW) {
        int r = it; MatDesc d;
        if (r < I_IN) { d = MatDesc{F.w_in, nullptr, F.gain1, (bf16*)(ws + OFF_WIN), DM, DIN, DIN, 1}; }
        else if ((r -= I_IN) < I_GLU) { d = MatDesc{F.w_glu, nullptr, nullptr, (bf16*)(ws + OFF_WGLU), DS, DS, DS, 0}; }
        else if ((r -= I_GLU) < I_BR) { d = MatDesc{F.w_branch, nullptr, nullptr, (bf16*)(ws + OFF_WA), DA, DM, DM, 0}; }
        else if ((r -= I_BR) < I_BR) { d = MatDesc{F.w_branch + (size_t)DA * DM, nullptr, nullptr, (bf16*)(ws + OFF_WS), DS, DM, DM, 0}; }
        else if ((r -= I_BR) < I_OUT) { d = MatDesc{F.w_out, nullptr, nullptr, (bf16*)(ws + OFF_WOUT), DM, DM, DM, 0}; }
        else if ((r -= I_OUT) < NEX * I_GU) { const int e = r / I_GU; r %= I_GU;
            d = MatDesc{F.w_eg + (size_t)e * DM * DEX, F.w_eu + (size_t)e * DM * DEX, F.gain2, (bf16*)(ws + OFF_WGU) + (size_t)e * 512 * DM, DM, 512, DEX, 2}; }
        else { r -= NEX * I_GU; const int e = r / I_D; r %= I_D;
            d = MatDesc{F.w_ed + (size_t)e * DEX * DM, nullptr, nullptr, (bf16*)(ws + OFF_WD) + (size_t)e * DM * DEX, DEX, DM, DM, 0}; }
        p0_item(d, scr, r, F.lane);
    }
}

struct SchedPlain {
    pg::TileOrder o; const char* A; const char* B; int lda_b, ldb_b, nseg, khalf_b; size_t segA, segB;
    __device__ __forceinline__ bool next(int i, pg::Unit& u) const {
        const int ti = (nseg == 2) ? (i >> 1) : i, s = (nseg == 2) ? (i & 1) : 0; int pm, pn;
        if (!o.tile(ti, pm, pn)) return false;
        u.A = A + (size_t)pm * 256 * lda_b + s * segA; u.B = B + (size_t)pn * 256 * ldb_b + s * segB; u.list = nullptr; u.pm = pm; u.pn = pn; u.cnt = 256; u.aux = s;
        u.flags = (s == 0 ? pg::UF_FIRST : 0) | (s == nseg - 1 ? pg::UF_LAST : 0); return true;
    }
};
__device__ __forceinline__ float fast_sigmoid(float x) { return __builtin_amdgcn_rcpf(1.0f + __builtin_amdgcn_exp2f(-LOG2E * x)); }

struct EpiInproj {
    static constexpr bool PERM = true, AFTER_DRAIN = false;
    bf16 *Q, *K, *V, *U, *GT; const float *rstd, *q_gain, *k_gain, *b_gate;
    __device__ __forceinline__ void mid(pg::Acc&, const pg::Unit&, int, int, int, int) const {}
    __device__ __forceinline__ void operator()(pg::Acc& acc, const pg::Unit& u, int wr, int wc, int fr, int fq) const {
        const int row0 = u.pm * 256 + wr * 64 + fr, pn = u.pn;
        float rsv[2][4];
#pragma unroll
        for (int ai = 0; ai < 2; ++ai)
#pragma unroll
            for (int m = 0; m < 4; ++m) rsv[ai][m] = rstd[row0 + ai * 128 + m * 16];
        if (pn < 4) {
            const bool isq = pn < 2; const float* gn = isq ? q_gain : k_gain; const float sc = isq ? QSCALE : 1.0f;
            bf16* base = (isq ? Q : K) + (4 * (pn & 1) + wc) * HD + 8 * fq;
            f32x4 gv[2][2];
#pragma unroll
            for (int bj = 0; bj < 2; ++bj)
#pragma unroll
                for (int n = 0; n < 2; ++n) gv[bj][n] = *(const f32x4*)(gn + 32 * bj + 8 * fq + 4 * n) * sc;
#pragma unroll
            for (int ai = 0; ai < 2; ++ai)
#pragma unroll
                for (int m = 0; m < 4; ++m) { const int row = row0 + ai * 128 + m * 16; const float rs = rsv[ai][m];
                    f32x4 v[2][2]; float ss = 0.f;
#pragma unroll
                    for (int bj = 0; bj < 2; ++bj)
#pragma unroll
                        for (int n = 0; n < 2; ++n) { v[bj][n] = acc[ai][bj][m][n] * rs; const f32x4 q = v[bj][n] * v[bj][n]; ss += (q[0] + q[1]) + (q[2] + q[3]); }
                    ss += __shfl_xor(ss, 16); ss += __shfl_xor(ss, 32);
                    const float r = 1.0f / sqrtf(ss * (1.0f / HD) + EPS);
#pragma unroll
                    for (int bj = 0; bj < 2; ++bj) { const f32x4 a = v[bj][0] * gv[bj][0] * r, b = v[bj][1] * gv[bj][1] * r;
                        pg::u32x4 w; w.x = pg::cvt_pk_bf16(a[0], a[1]); w.y = pg::cvt_pk_bf16(a[2], a[3]); w.z = pg::cvt_pk_bf16(b[0], b[1]); w.w = pg::cvt_pk_bf16(b[2], b[3]);
                        *(pg::u32x4*)(base + (size_t)row * DA + 32 * bj) = w; } }
        } else if (pn < 8) {
            const bool isv = pn < 6;
#pragma unroll
            for (int ai = 0; ai < 2; ++ai)
#pragma unroll
                for (int m = 0; m < 4; ++m) { const int row = row0 + ai * 128 + m * 16; const float rs = rsv[ai][m];
#pragma unroll
                    for (int bj = 0; bj < 2; ++bj) { const f32x4 a = acc[ai][bj][m][0] * rs, b = acc[ai][bj][m][1] * rs;
                        pg::u32x4 w; w.x = pg::cvt_pk_bf16(a[0], a[1]); w.y = pg::cvt_pk_bf16(a[2], a[3]); w.z = pg::cvt_pk_bf16(b[0], b[1]); w.w = pg::cvt_pk_bf16(b[2], b[3]);
                        const int col = (pn & 1) * 256 + bj * 128 + wc * 32 + 8 * fq;
                        bf16* dst = isv ? V + (size_t)row * DA + col : U + ((size_t)(col >> 4) * T + row) * SGC + (col & 15);
                        *(pg::u32x4*)dst = w; } }
        } else {
            const int nm0 = (pn - 8) * 128 + 32 * wc + 8 * fq;
            f32x4 bv[2][2];
#pragma unroll
            for (int bj = 0; bj < 2; ++bj)
#pragma unroll
                for (int n = 0; n < 2; ++n) bv[bj][n] = *(const f32x4*)(b_gate + bj * DM + nm0 + 4 * n);
            unsigned char* G8 = (unsigned char*)GT;
#pragma unroll
            for (int ai = 0; ai < 2; ++ai)
#pragma unroll
                for (int m = 0; m < 4; ++m) { const int row = row0 + ai * 128 + m * 16; const float rs = rsv[ai][m]; pg::u32x4 w;
#pragma unroll
                    for (int bj = 0; bj < 2; ++bj)
#pragma unroll
                        for (int n = 0; n < 2; ++n) { const f32x4 a = acc[ai][bj][m][n] * rs + bv[bj][n]; unsigned pk = 0u;
#pragma unroll
                            for (int i = 0; i < 4; ++i) { const float g = fast_sigmoid(a[i]); const unsigned q = (unsigned)__builtin_fminf(__builtin_fmaxf(g * 255.0f + 0.5f, 1.0f), 255.0f); pk |= q << (8 * i); }
                            w[2 * bj + n] = pk; }
                    *(pg::u32x4*)(G8 + (size_t)row * (2 * DM) + (size_t)(nm0 >> 3) * 16) = w; }
        }
    }
};
__device__ __forceinline__ void unpack8(const pg::u32x4 w, f32x4& a, f32x4& b) { a = (f32x4){bflo(w.x), bfhi(w.x), bflo(w.y), bfhi(w.y)}; b = (f32x4){bflo(w.z), bfhi(w.z), bflo(w.w), bfhi(w.w)}; }
struct EpiGlu {
    static constexpr bool PERM = true, AFTER_DRAIN = false;
    const bf16* Z; bf16* YS; const float* b_glu;
    __device__ __forceinline__ void mid(pg::Acc&, const pg::Unit&, int, int, int, int) const {}
    __device__ __forceinline__ void operator()(pg::Acc& acc, const pg::Unit& u, int wr, int wc, int fr, int fq) const {
        const int row0 = u.pm * 256 + wr * 64 + fr, col0 = u.pn * 256 + wc * 32 + 8 * fq;
        f32x4 bv[2][2];
#pragma unroll
        for (int bj = 0; bj < 2; ++bj)
#pragma unroll
            for (int n = 0; n < 2; ++n) bv[bj][n] = *(const f32x4*)(b_glu + col0 + bj * 128 + 4 * n);
#pragma unroll
        for (int ai = 0; ai < 2; ++ai)
#pragma unroll
            for (int m = 0; m < 4; ++m) { const size_t ro = (size_t)(row0 + ai * 128 + m * 16) * DS + col0;
#pragma unroll
                for (int bj = 0; bj < 2; ++bj) { f32x4 z0, z1; unpack8(*(const pg::u32x4*)(Z + ro + bj * 128), z0, z1);
                    const f32x4 a = acc[ai][bj][m][0] + bv[bj][0], b = acc[ai][bj][m][1] + bv[bj][1];
                    pg::u32x4 w; w.x = pg::cvt_pk_bf16(z0[0] * fast_sigmoid(a[0]), z0[1] * fast_sigmoid(a[1])); w.y = pg::cvt_pk_bf16(z0[2] * fast_sigmoid(a[2]), z0[3] * fast_sigmoid(a[3]));
                    w.z = pg::cvt_pk_bf16(z1[0] * fast_sigmoid(b[0]), z1[1] * fast_sigmoid(b[1])); w.w = pg::cvt_pk_bf16(z1[2] * fast_sigmoid(b[2]), z1[3] * fast_sigmoid(b[3]));
                    *(pg::u32x4*)(YS + ro + bj * 128) = w; } }
    }
};
__device__ __forceinline__ void unpack_u8x4(unsigned w, f32x4& o) { o = (f32x4){(float)(w & 255u), (float)((w >> 8) & 255u), (float)((w >> 16) & 255u), (float)(w >> 24)}; }
struct EpiBranch {
    static constexpr bool PERM = true, AFTER_DRAIN = false;
    const unsigned char* G8; bf16* MG;
    __device__ __forceinline__ void mid(pg::Acc& acc, const pg::Unit& u, int wr, int wc, int fr, int fq) const {
        const int row0 = u.pm * 256 + wr * 64 + fr, blk0 = u.pn * 32 + wc * 4 + fq;
#pragma unroll
        for (int ai = 0; ai < 2; ++ai) { pg::u32x4 g[4][2];
#pragma unroll
            for (int m = 0; m < 4; ++m)
#pragma unroll
                for (int bj = 0; bj < 2; ++bj) g[m][bj] = *(const pg::u32x4*)(G8 + (size_t)(row0 + ai * 128 + m * 16) * (2 * DM) + (size_t)(blk0 + 16 * bj) * 16);
#pragma unroll
            for (int m = 0; m < 4; ++m)
#pragma unroll
                for (int bj = 0; bj < 2; ++bj) { f32x4 a0, a1, b0, b1; unpack_u8x4(g[m][bj].x, a0); unpack_u8x4(g[m][bj].y, a1); unpack_u8x4(g[m][bj].z, b0); unpack_u8x4(g[m][bj].w, b1);
#pragma unroll
                    for (int i = 0; i < 4; ++i) { acc[ai][bj][m][0][i] *= a0[i] * __builtin_amdgcn_rcpf(b0[i]); acc[ai][bj][m][1][i] *= a1[i] * __builtin_amdgcn_rcpf(b1[i]); } } }
    }
    __device__ __forceinline__ void operator()(pg::Acc& acc, const pg::Unit& u, int wr, int wc, int fr, int fq) const {
        const int row0 = u.pm * 256 + wr * 64 + fr, col0 = u.pn * 256 + wc * 32 + 8 * fq, blk0 = u.pn * 32 + wc * 4 + fq;
#pragma unroll
        for (int ai = 0; ai < 2; ++ai) { pg::u32x2 g[4][2];
#pragma unroll
            for (int m = 0; m < 4; ++m)
#pragma unroll
                for (int bj = 0; bj < 2; ++bj) g[m][bj] = *(const pg::u32x2*)(G8 + (size_t)(row0 + ai * 128 + m * 16) * (2 * DM) + (size_t)(blk0 + 16 * bj) * 16 + 8);
#pragma unroll
            for (int m = 0; m < 4; ++m)
#pragma unroll
                for (int bj = 0; bj < 2; ++bj) { f32x4 g0, g1; unpack_u8x4(g[m][bj].x, g0); unpack_u8x4(g[m][bj].y, g1); const f32x4 a = acc[ai][bj][m][0] * g0 * (1.0f / 255.0f), b = acc[ai][bj][m][1] * g1 * (1.0f / 255.0f);
                    pg::u32x4 w; w.x = pg::cvt_pk_bf16(a[0], a[1]); w.y = pg::cvt_pk_bf16(a[2], a[3]); w.z = pg::cvt_pk_bf16(b[0], b[1]); w.w = pg::cvt_pk_bf16(b[2], b[3]);
                    *(pg::u32x4*)(MG + (size_t)(row0 + ai * 128 + m * 16) * DM + col0 + bj * 128) = w; } }
    }
};
struct EpiOut {
    static constexpr bool PERM = true, AFTER_DRAIN = false;
    bf16* XB;
    __device__ __forceinline__ void mid(pg::Acc&, const pg::Unit&, int, int, int, int) const {}
    __device__ __forceinline__ void operator()(pg::Acc& acc, const pg::Unit& u, int wr, int wc, int fr, int fq) const {
        const int row0 = u.pm * 256 + wr * 64 + fr, col0 = u.pn * 256 + wc * 32 + 8 * fq;
        pg::u32x4 xv[2][4][2];
#pragma unroll
        for (int ai = 0; ai < 2; ++ai)
#pragma unroll
            for (int m = 0; m < 4; ++m)
#pragma unroll
                for (int bj = 0; bj < 2; ++bj) xv[ai][m][bj] = *(const pg::u32x4*)(XB + (size_t)(row0 + ai * 128 + m * 16) * DM + col0 + bj * 128);
#pragma unroll
        for (int ai = 0; ai < 2; ++ai)
#pragma unroll
            for (int m = 0; m < 4; ++m)
#pragma unroll
                for (int bj = 0; bj < 2; ++bj) { f32x4 x0, x1; unpack8(xv[ai][m][bj], x0, x1); const f32x4 a = x0 + acc[ai][bj][m][0], b = x1 + acc[ai][bj][m][1];
                    pg::u32x4 w; w.x = pg::cvt_pk_bf16(a[0], a[1]); w.y = pg::cvt_pk_bf16(a[2], a[3]); w.z = pg::cvt_pk_bf16(b[0], b[1]); w.w = pg::cvt_pk_bf16(b[2], b[3]);
                    *(pg::u32x4*)(XB + (size_t)(row0 + ai * 128 + m * 16) * DM + col0 + bj * 128) = w; }
    }
};
constexpr int MOE_TAB_OFF = LDSCTL_OFF + 1024;
__device__ __forceinline__ void moe_build_tab(Frame& F) {
    LAS int* tab = (LAS int*)((LAS unsigned char*)F.lds + MOE_TAB_OFF);
    if (F.tid < NCLS) tab[32 + F.tid] = (int)__hip_atomic_load(F.ctl + CW_CNT + 64 * F.tid, __ATOMIC_RELAXED, __HIP_MEMORY_SCOPE_AGENT);
    __syncthreads();
    if (F.tid == 0) { int acc = 0;
        for (int c = 0; c < NCLS; ++c) { tab[c] = acc; acc += (tab[32 + c] + 255) >> 8; }
        tab[NCLS] = acc; }
    __syncthreads();
}
struct SchedMoe {
    const LAS int* tab; int G, c, nseg, mode; const char* A; const char* B; const int* LIST;
    __device__ __forceinline__ bool next(int i, pg::Unit& u) const {
        const int ti = (nseg == 2) ? (i >> 1) : i, s = (nseg == 2) ? (i & 1) : 0;
        const int L = ti * G + c; if (L >= tab[NCLS] * 4) return false;
        const int tileIdx = L >> 2, pn = L & 3; int cls = 0;
        while (tab[cls + 1] <= tileIdx) ++cls;
        const int tile = tileIdx - tab[cls]; int cnt = tab[32 + cls] - tile * 256; cnt = cnt > 256 ? 256 : cnt;
        const int grp = cls / 6; int lo, hi; pair_decode(cls % 6, lo, hi);
        u.list = LIST + (size_t)cls * T + tile * 256; u.cnt = cnt; u.pm = cls; u.pn = pn;
        if (mode == 0) { const int e = grp * 4 + ((pn >> 1) ? hi : lo); u.A = A; u.B = B + ((size_t)e * 512 + (pn & 1) * 256) * (DM * 2); u.aux = pn >> 1; }
        else { u.A = A; u.B = B + ((size_t)(grp * 4 + lo) * DM + pn * 256) * (DEX * 2); u.aux = (hi - lo) * DM * DEX * 2; }
        u.flags = (s == 0 ? pg::UF_FIRST : 0) | (s == nseg - 1 ? pg::UF_LAST : 0); return true;
    }
};
struct EpiGateUp {
    static constexpr bool PERM = true, AFTER_DRAIN = false;
    bf16* HID; const float* rstd2; const float* tokw;
    __device__ __forceinline__ void mid(pg::Acc&, const pg::Unit&, int, int, int, int) const {}
    __device__ __forceinline__ void operator()(pg::Acc& acc, const pg::Unit& u, int wr, int wc, int fr, int fq) const {
        const int slot = u.aux, hcol = slot * DEX + (u.pn & 1) * 128 + 32 * wc + 8 * fq;
#pragma unroll
        for (int ai = 0; ai < 2; ++ai) { int tok[4]; float rs[4], ww[4];
#pragma unroll
            for (int m = 0; m < 4; ++m) { const int r = ai * 128 + wr * 64 + m * 16 + fr; tok[m] = u.list[r < u.cnt ? r : 0]; }
#pragma unroll
            for (int m = 0; m < 4; ++m) { rs[m] = rstd2[tok[m]]; ww[m] = tokw[2 * tok[m] + slot]; }
#pragma unroll
            for (int m = 0; m < 4; ++m) { const int r = ai * 128 + wr * 64 + m * 16 + fr;
                if (r < u.cnt) { pg::u32x4 o;
#pragma unroll
                    for (int n = 0; n < 2; ++n) { const f32x4 g = acc[ai][0][m][n] * rs[m], up = acc[ai][1][m][n] * rs[m]; f32x4 h;
#pragma unroll
                        for (int i = 0; i < 4; ++i) h[i] = g[i] * fast_sigmoid(g[i]) * up[i] * ww[m];
                        o[2 * n] = pg::cvt_pk_bf16(h[0], h[1]); o[2 * n + 1] = pg::cvt_pk_bf16(h[2], h[3]); }
                    *(pg::u32x4*)(HID + (size_t)tok[m] * 512 + hcol) = o; } } }
    }
};
struct EpiDown {
    static constexpr bool PERM = false, AFTER_DRAIN = false;
    float* out; const bf16* XB;
    __device__ __forceinline__ void mid(pg::Acc&, const pg::Unit&, int, int, int, int) const {}
    __device__ __forceinline__ void operator()(pg::Acc& acc, const pg::Unit& u, int wr, int wc, int fr, int fq) const {
        const int col0 = u.pn * 256 + wc * 32 + 4 * fq;
        int tok[2][4];
#pragma unroll
        for (int ai = 0; ai < 2; ++ai)
#pragma unroll
            for (int m = 0; m < 4; ++m) { const int r = ai * 128 + wr * 64 + m * 16 + fr; tok[ai][m] = u.list[r < u.cnt ? r : 0]; }
#pragma unroll
        for (int ai = 0; ai < 2; ++ai)
#pragma unroll
            for (int mp = 0; mp < 2; ++mp) { pg::u32x2 xb[2][2][2];
#pragma unroll
                for (int mm = 0; mm < 2; ++mm)
#pragma unroll
                    for (int bj = 0; bj < 2; ++bj)
#pragma unroll
                        for (int n = 0; n < 2; ++n) xb[mm][bj][n] = *(const pg::u32x2*)(XB + (size_t)tok[ai][2 * mp + mm] * DM + col0 + bj * 128 + n * 16);
#pragma unroll
                for (int mm = 0; mm < 2; ++mm) { const int m = 2 * mp + mm, r = ai * 128 + wr * 64 + m * 16 + fr;
                    if (r < u.cnt) {
#pragma unroll
                        for (int bj = 0; bj < 2; ++bj)
#pragma unroll
                            for (int n = 0; n < 2; ++n) { const pg::u32x2 w = xb[mm][bj][n];
                                *(f32x4*)(out + (size_t)tok[ai][m] * DM + col0 + bj * 128 + n * 16) = (f32x4){bflo(w.x), bfhi(w.x), bflo(w.y), bfhi(w.y)} + acc[ai][bj][m][n]; } } } }
    }
};
namespace att {
typedef short bf16x8 __attribute__((ext_vector_type(8)));
typedef short s16x4 __attribute__((ext_vector_type(4)));
typedef float f32x16 __attribute__((ext_vector_type(16)));
typedef short v4i16_t __attribute__((ext_vector_type(4)));
constexpr int SLOT = 32768, RING = 3 * SLOT, NBT = 384, BIAS_OFF = RING, WS_OFF = BIAS_OFF + 2 * NBT * 4, OST_OFF = 0;
__device__ __forceinline__ int crow(int r, int hi) { return (r & 3) + 8 * (r >> 2) + 4 * hi; }
__device__ __forceinline__ s16x4 vtr(const LAS unsigned char* p) { return __builtin_bit_cast(s16x4, __builtin_amdgcn_ds_read_tr16_b64_v4i16((LAS v4i16_t*)p)); }
__device__ __forceinline__ float max3f(float a, float b, float c) { return __builtin_fmaxf(__builtin_fmaxf(a, b), c); }
#define ATT_WAIT_BAR(N) asm volatile("s_waitcnt vmcnt(" #N ") lgkmcnt(0)\n\ts_barrier" ::: "memory")

struct AttState { float m, l; f32x16 o[2]; };
template <int SLC>
__device__ __forceinline__ void att_step(LAS unsigned char* L, int j, int ci, int hh, int qi, int r32, int hi, int lane, const bf16x8 (&qr)[4], const LAS float* biasL, LAS float* wsf, AttState& S) {
    if (j >= ci && j <= ci + LEFT) {
        const int dc = ci + LEFT - j;
        const LAS unsigned char* Kb = L + SLC * SLOT + hh * 16384; const LAS unsigned char* Vb = Kb + 8192;
        f32x16 p0, p1;
        if (dc >= 5) { const float bc = biasL[NREL - 1] - S.m;
#pragma unroll
            for (int r = 0; r < 16; ++r) { p0[r] = bc; p1[r] = bc; } }
        else { const LAS float* bp = biasL + (64 * dc + qi + 4 - 4 * hi);
#pragma unroll
            for (int r = 0; r < 16; ++r) { const int k = (r & 3) + 8 * (r >> 2); p0[r] = bp[59 - k] - S.m; p1[r] = bp[27 - k] - S.m; } }
        { const LAS unsigned char* kb = Kb + r32 * 128;
#pragma unroll
          for (int d0 = 0; d0 < 4; ++d0) { const int sl = ((2 * d0 + hi) ^ (r32 & 7)) << 4; const bf16x8 b0 = *(const LAS bf16x8*)(kb + sl), b1 = *(const LAS bf16x8*)(kb + 4096 + sl);
              p0 = __builtin_amdgcn_mfma_f32_32x32x16_bf16(b0, qr[d0], p0, 0, 0, 0); p1 = __builtin_amdgcn_mfma_f32_32x32x16_bf16(b1, qr[d0], p1, 0, 0, 0); } }
        float rm;
        { float a = max3f(p0[0], p0[1], p1[0]), bb = max3f(p0[2], p0[3], p1[1]); a = max3f(a, p1[2], p1[3]);
#pragma unroll
          for (int r = 4; r < 16; r += 4) { a = max3f(a, p0[r], p0[r + 1]); bb = max3f(bb, p0[r + 2], p0[r + 3]); a = max3f(a, p1[r], p1[r + 1]); bb = max3f(bb, p1[r + 2], p1[r + 3]); }
          rm = __builtin_fmaxf(a, bb); { const auto rr = __builtin_amdgcn_permlane32_swap(__float_as_uint(rm), __float_as_uint(rm), false, false); rm = __builtin_fmaxf(__uint_as_float(rr[0]), __uint_as_float(rr[1])); } }
        if (__any(rm > 8.0f)) {
            const float dl = __builtin_fmaxf(rm, 0.f), alpha = __builtin_amdgcn_exp2f(-dl); S.m += dl; S.l *= alpha;
            if (hi == 0) wsf[r32] = alpha;
#pragma unroll
            for (int r = 0; r < 16; ++r) { p0[r] -= dl; p1[r] -= dl; }
            asm volatile("s_waitcnt lgkmcnt(0)" ::: "memory");
#pragma unroll
            for (int r = 0; r < 16; ++r) { const float f = wsf[crow(r, hi)]; S.o[0][r] *= f; S.o[1][r] *= f; }
        }
        float sacc = 0.f;
#pragma unroll
        for (int r = 0; r < 16; ++r) { p0[r] = __builtin_amdgcn_exp2f(p0[r]); p1[r] = __builtin_amdgcn_exp2f(p1[r]); sacc += p0[r] + p1[r]; }
        S.l += sacc;
        pg::u32x4 pw[4];
#pragma unroll
        for (int k = 0; k < 2; ++k) { pw[k] = (pg::u32x4){pg::cvt_pk_bf16(p0[8 * k], p0[8 * k + 1]), pg::cvt_pk_bf16(p0[8 * k + 2], p0[8 * k + 3]), pg::cvt_pk_bf16(p0[8 * k + 4], p0[8 * k + 5]), pg::cvt_pk_bf16(p0[8 * k + 6], p0[8 * k + 7])};
            pw[2 + k] = (pg::u32x4){pg::cvt_pk_bf16(p1[8 * k], p1[8 * k + 1]), pg::cvt_pk_bf16(p1[8 * k + 2], p1[8 * k + 3]), pg::cvt_pk_bf16(p1[8 * k + 4], p1[8 * k + 5]), pg::cvt_pk_bf16(p1[8 * k + 6], p1[8 * k + 7])}; }
        const int vb = (int)(unsigned)(__UINTPTR_TYPE__)(Vb + ((lane >> 4) & 1) * 32 + (lane & 3) * 8 + (4 * hi + ((lane & 15) >> 2)) * 64);
#pragma unroll
        for (int d0 = 0; d0 < 2; ++d0) { s16x4 lo[4], hq[4];
#pragma unroll
            for (int ks = 0; ks < 4; ++ks) {
                asm volatile("ds_read_b64_tr_b16 %0, %1 offset:%c2" : "=&v"(lo[ks]) : "v"(vb), "i"(d0 * 4096 + ks * 1024) : "memory");
                asm volatile("ds_read_b64_tr_b16 %0, %1 offset:%c2" : "=&v"(hq[ks]) : "v"(vb), "i"(d0 * 4096 + ks * 1024 + 512) : "memory"); }
            asm volatile("s_waitcnt lgkmcnt(0)" ::: "memory"); __builtin_amdgcn_sched_barrier(0);
#pragma unroll
            for (int ks = 0; ks < 4; ++ks) { const bf16x8 vf = (bf16x8){lo[ks][0], lo[ks][1], lo[ks][2], lo[ks][3], hq[ks][0], hq[ks][1], hq[ks][2], hq[ks][3]};
                S.o[d0] = __builtin_amdgcn_mfma_f32_32x32x16_bf16(__builtin_bit_cast(bf16x8, pw[ks]), vf, S.o[d0], 0, 0, 0); } }
    }
}
__device__ __forceinline__ void attn_unit(Frame& F, int b, int hp, int cp) {
    LAS unsigned char* L = (LAS unsigned char*)F.lds;
    const int tid = F.tid, lane = F.lane, r32 = lane & 31, hi = lane >> 5, wid = F.wave;
    const int hh = wid >> 2, h = 2 * hp + hh, qb = wid & 3, ci = qb >> 1, qh = qb & 1, c0 = 2 * cp;
    const int trow = b * SEQ + (c0 + ci) * CHK + qh * 32;
    const LAS float* biasL = (const LAS float*)(L + BIAS_OFF) + hh * NBT;
    LAS float* wsf = (LAS float*)(L + WS_OFF) + wid * 64;
    for (int idx = tid; idx < 2 * NBT; idx += NTHR) { const int hd = idx / NBT, e = idx % NBT; ((LAS float*)(L + BIAS_OFF))[idx] = F.rel_bias[(2 * hp + hd) * NREL + (e < NREL ? e : NREL - 1)] * LOG2E; }
    bf16x8 qr[4];
#pragma unroll
    for (int d0 = 0; d0 < 4; ++d0) qr[d0] = *(const bf16x8*)(F.Q + (size_t)(trow + r32) * DA + h * HD + d0 * 16 + hi * 8);
    const int j0 = c0 >= LEFT ? 0 : LEFT - c0;
    const long krow0 = (long)b * SEQ + (long)(c0 - LEFT) * CHK;
    const bf16* ksrc = F.K + (2 * hp) * HD + (((lane & 7) ^ (lane >> 3)) << 3) + (long)(8 * wid + (lane >> 3)) * DA;
    const bf16* vsrc = F.V + (2 * hp) * HD + (wid >> 2) * 32 + (lane & 3) * 8 + (long)(16 * (wid & 3) + (lane >> 2)) * DA;
    const unsigned pieceoff = (unsigned)wid * 1024u;
#define ATT_ISSUE(jt, SL) do { const long ro_ = (krow0 + (long)(jt) * CHK) * DA; \
        __builtin_amdgcn_global_load_lds((const unsigned*)(ksrc + ro_), (LAS unsigned*)(L + (SL) * SLOT + pieceoff), 16, 0, 0); \
        __builtin_amdgcn_global_load_lds((const unsigned*)(vsrc + ro_), (LAS unsigned*)(L + (SL) * SLOT + 8192 + pieceoff), 16, 0, 0); \
        __builtin_amdgcn_global_load_lds((const unsigned*)(ksrc + ro_ + HD), (LAS unsigned*)(L + (SL) * SLOT + 16384 + pieceoff), 16, 0, 0); \
        __builtin_amdgcn_global_load_lds((const unsigned*)(vsrc + ro_ + HD), (LAS unsigned*)(L + (SL) * SLOT + 24576 + pieceoff), 16, 0, 0); } while (0)
    ATT_ISSUE(j0, 0);
    if (j0 + 1 < 10) ATT_ISSUE(j0 + 1, 1);
    AttState S; S.m = -1000.f; S.l = 0.f;
#pragma unroll
    for (int r = 0; r < 16; ++r) { S.o[0][r] = 0.f; S.o[1][r] = 0.f; }
    const int qi = qh * 32 + r32;
    if (j0 + 1 < 10) ATT_WAIT_BAR(4); else ATT_WAIT_BAR(0);
#define ATT_STEPX(SLC) { if (j + 2 < 10) ATT_ISSUE(j + 2, ((SLC) + 2) % 3); att_step<SLC>(L, j, ci, hh, qi, r32, hi, lane, qr, biasL, wsf, S); if (j + 2 < 10) ATT_WAIT_BAR(4); else ATT_WAIT_BAR(0); if (++j >= 10) break; }
    { int j = j0;
#pragma unroll 1
      for (;;) { ATT_STEPX(0) ATT_STEPX(1) ATT_STEPX(2) } }
#undef ATT_STEPX
#undef ATT_ISSUE
    float l = S.l; l += __shfl_xor(l, 32);
    if (hi == 0) wsf[32 + r32] = 1.0f / l;
    asm volatile("s_waitcnt lgkmcnt(0)" ::: "memory");
    LAS bf16* stg = (LAS bf16*)(L + OST_OFF) + wid * 2048;
#pragma unroll
    for (int r = 0; r < 16; ++r) { const int orow = crow(r, hi); const float f = wsf[32 + orow];
        stg[orow * 64 + r32] = (bf16)f2bf(S.o[0][r] * f); stg[orow * 64 + 32 + r32] = (bf16)f2bf(S.o[1][r] * f); }
    asm volatile("s_waitcnt lgkmcnt(0)" ::: "memory");
    bf16* Ow = F.YA + (size_t)trow * DA + h * HD;
#pragma unroll
    for (int i = 0; i < 4; ++i) { const int row = i * 8 + (lane >> 3), ch = lane & 7; const v4u v = *(const LAS v4u*)(stg + row * 64 + ch * 8); *(v4u*)(Ow + (size_t)row * DA + ch * 8) = v; }
    ATT_WAIT_BAR(0);
}
__device__ __forceinline__ void attn_phase(Frame& F) {
    volatile LAS int* qslot = (volatile LAS int*)((LAS unsigned char*)F.lds + LDSCTL_OFF + 2048);
#pragma unroll 1
    for (;;) {
        if (F.tid == 0) *qslot = (int)xb_add(F.ctl + CW_ATTQ, 1u);
        __syncthreads();
        const int q = *qslot;
        __syncthreads();
        if (q >= NB * 4 * 16) break;
        int pr, cp;
        if (q < 64 * 12) { pr = q / 12; cp = 4 + q % 12; } else { const int r = q - 64 * 12; cp = 3 - (r >> 6); pr = r & 63; }
        attn_unit(F, pr >> 2, pr & 3, cp);
    }
}
#undef ATT_WAIT_BAR
}

constexpr size_t OFF_SLOC = 384 * MiB, OFF_SIN = 400 * MiB;
constexpr size_t TAB_A = 0, TAB_A32 = 16 * 1024, TAB_A64 = 32 * 1024, TAB_BB = 64 * 1024, TAB_CM = 256 * 1024;
typedef float f32x2v __attribute__((ext_vector_type(2)));
struct SsmCoef { float lre, lim, step, a_re, a_im, f_re, f_im; };
__device__ __forceinline__ SsmCoef ssm_coef(const Frame& F, int g, int p) {
    SsmCoef c; c.lre = F.lam_re[g * NST + p]; c.lim = F.lam_im[g * NST + p]; c.step = expf(F.log_step[g]);
    const float mag = expf(c.lre * c.step), ang = c.lim * c.step; c.a_re = mag * cosf(ang); c.a_im = mag * sinf(ang);
    const float nr = c.a_re - 1.0f, ni = c.a_im, den = c.lre * c.lre + c.lim * c.lim;
    c.f_re = (nr * c.lre + ni * c.lim) / den; c.f_im = (ni * c.lre - nr * c.lim) / den; return c;
}
__device__ __forceinline__ f32x2v ssm_apow(const SsmCoef& c, int n) { const float mag = expf((float)n * c.lre * c.step), ang = (float)n * (c.lim * c.step); return (f32x2v){mag * cosf(ang), mag * sinf(ang)}; }
__device__ __forceinline__ void ph_ssmtab(Frame& F, unsigned char* ws, int thr0) {
    unsigned char* tab = ws + OFF_TAB;
    const int gt = F.vcu * (NTHR - thr0) + (F.tid - thr0), NT_ = F.G * (NTHR - thr0);
    for (int idx = gt; idx < NGR * NST; idx += NT_) { const int g = idx / NST, p = idx % NST; const SsmCoef c = ssm_coef(F, g, p);
        ((f32x2v*)(tab + TAB_A))[idx] = (f32x2v){c.a_re, c.a_im}; ((f32x2v*)(tab + TAB_A32))[idx] = ssm_apow(c, 32); ((f32x2v*)(tab + TAB_A64))[idx] = ssm_apow(c, 64); }
    for (int idx = gt; idx < NGR * 4 * 64; idx += NT_) { const int lane = idx & 63, st = (idx >> 6) & 3, g = idx >> 8, p = 32 * (st >> 1) + (lane & 31), part = st & 1;
        const SsmCoef c = ssm_coef(F, g, p); unsigned w[4];
#pragma unroll
        for (int j = 0; j < 8; j += 2) { float v[2];
#pragma unroll
            for (int q = 0; q < 2; ++q) { const int ch = 8 * (lane >> 5) + j + q; const float br = F.sb_re[(g * NST + p) * SGC + ch], bi = F.sb_im[(g * NST + p) * SGC + ch]; v[q] = part ? (c.f_re * bi + c.f_im * br) : (c.f_re * br - c.f_im * bi); }
            w[j >> 1] = pk2(v[0], v[1]); }
        ((v4u*)(tab + TAB_BB))[idx] = (v4u){w[0], w[1], w[2], w[3]}; }
    for (int idx = gt; idx < NGR * 5 * 64; idx += NT_) { const int lane = idx & 63, ks = (idx >> 6) % 5, g = idx / 320, col = lane & 15; unsigned w[4];
#pragma unroll
        for (int j = 0; j < 8; j += 2) { float v[2];
#pragma unroll
            for (int q = 0; q < 2; ++q) { const int k = 8 * (lane >> 4) + j + q + 32 * ks;
                if (ks < 4) { const int p = k >> 1; v[q] = (k & 1) ? -F.sc_im[(g * SGC + col) * NST + p] : F.sc_re[(g * SGC + col) * NST + p]; }
                else { const int kk = k - 128; v[q] = (kk == col) ? F.ssm_d[g * SGC + col] : 0.f; } }
            w[j >> 1] = pk2(v[0], v[1]); }
        ((v4u*)(tab + TAB_CM))[idx] = (v4u){w[0], w[1], w[2], w[3]}; }
    bf16* W = (bf16*)(ws + OFF_WSSM);
    for (int idx = gt; idx < NGR * 256 * 8; idx += NT_) { const int jb = idx & 7, n = (idx >> 3) & 255, g = idx >> 11, p = (n & 127) >> 1, part = n & 1, e0 = ((n >> 7) ? 24 : 56) - 8 * jb;
        v4u* dst = (v4u*)(W + ((size_t)(g * 256 + n)) * 1024 + jb * 128);
        if (e0 < 0) {
#pragma unroll
            for (int q = 0; q < 16; ++q) dst[q] = (v4u){0u, 0u, 0u, 0u}; }
        else { const SsmCoef c = ssm_coef(F, g, p); const f32x2v pw = ssm_apow(c, e0); float gr = pw.x * c.f_re - pw.y * c.f_im, gi = pw.x * c.f_im + pw.y * c.f_re;
            float br[SGC], bi[SGC];
#pragma unroll
            for (int ch = 0; ch < SGC; ++ch) { br[ch] = F.sb_re[(g * NST + p) * SGC + ch]; bi[ch] = F.sb_im[(g * NST + p) * SGC + ch]; }
#pragma unroll
            for (int sI = 0; sI < 8; ++sI) { const int j = 7 - sI; unsigned w[8];
#pragma unroll
                for (int q = 0; q < 8; ++q) { const float v0 = part ? (gr * bi[2 * q] + gi * br[2 * q]) : (gr * br[2 * q] - gi * bi[2 * q]), v1 = part ? (gr * bi[2 * q + 1] + gi * br[2 * q + 1]) : (gr * br[2 * q + 1] - gi * bi[2 * q + 1]); w[q] = pk2(v0, v1); }
                dst[2 * j] = (v4u){w[0], w[1], w[2], w[3]}; dst[2 * j + 1] = (v4u){w[4], w[5], w[6], w[7]};
                const float ngr = gr * c.a_re - gi * c.a_im, ngi = gr * c.a_im + gi * c.a_re; gr = ngr; gi = ngi; } }
    }
}
struct SchedSloc {
    const char* U; const char* W; int c;
    __device__ __forceinline__ bool next(int i, pg::Unit& u) const {
        if (i != 0 || c >= NGR * 2) return false;
        const int g = c >> 1, mt = c & 1;
        u.A = U + ((size_t)g * T * SGC + (size_t)mt * 256 * 1024) * 2; u.B = W + (size_t)g * 256 * 1024 * 2; u.list = nullptr; u.pm = mt; u.pn = 0; u.cnt = 256; u.aux = g; u.flags = pg::UF_FIRST | pg::UF_LAST; return true;
    }
};
struct EpiSloc {
    static constexpr bool PERM = false, AFTER_DRAIN = true;
    float* SIN; const f32x2v* A32; const f32x2v* A64;
    __device__ __forceinline__ void mid(pg::Acc&, const pg::Unit&, int, int, int, int) const {}
    __device__ __forceinline__ void operator()(pg::Acc&, const pg::Unit&, int, int, int, int) const {}
    __device__ __forceinline__ void fused(pg::Acc& acc, const pg::Unit& u, int wr, int wc, int fr, int fq, LAS unsigned char* lds, int wid, int lane) const {
        LAS float* Lf = (LAS float*)lds;
        const int g = u.aux, tid = wid * 64 + lane, bl = tid >> 6, p = tid & 63, b = u.pm * 8 + bl;
        f32x2v sin[NCH];
#pragma unroll
        for (int half = 0; half < 2; ++half) {
#pragma unroll
            for (int ai = 0; ai < 2; ++ai)
#pragma unroll
                for (int m = 0; m < 4; ++m)
#pragma unroll
                    for (int n = 0; n < 2; ++n) { const int row = ai * 128 + wr * 64 + m * 16 + fr; *(LAS f32x4*)(Lf + row * 128 + (((8 * wc + 4 * n + fq) ^ (row & 31)) << 2)) = acc[ai][half][m][n]; }
            __syncthreads();
            float* sp = SIN + ((((size_t)b * NCH) * NGR + g) * 2 + half) * 128 + 2 * p;
            if (half == 0) { const f32x2v a = A64[g * NST + p]; f32x2v s = (f32x2v){0.f, 0.f};
#pragma unroll
                for (int c = 0; c < NCH; ++c) { sin[c] = s; *(f32x2v*)(sp + (size_t)c * NGR * 256) = s;
                    const f32x2v loc = *(const LAS f32x2v*)(Lf + (bl * 32 + c) * 128 + ((((p >> 1) ^ c) << 2) | ((2 * p) & 3))); s = (f32x2v){a.x * s.x - a.y * s.y + loc.x, a.x * s.y + a.y * s.x + loc.y}; } }
            else { const f32x2v a = A32[g * NST + p];
#pragma unroll
                for (int c = 0; c < NCH; ++c) { const f32x2v s = sin[c];
                    const f32x2v loc = *(const LAS f32x2v*)(Lf + (bl * 32 + c) * 128 + ((((p >> 1) ^ c) << 2) | ((2 * p) & 3))); *(f32x2v*)(sp + (size_t)c * NGR * 256) = (f32x2v){a.x * s.x - a.y * s.y + loc.x, a.x * s.y + a.y * s.x + loc.y}; } }
            __syncthreads();
        }
    }
};
namespace ssm {
typedef short bf16x8 __attribute__((ext_vector_type(8)));
typedef float f32x16 __attribute__((ext_vector_type(16)));
constexpr int SST_OFF = 0, ZT_OFF = 65536;
__device__ __forceinline__ float gelu_fast(float x) { return x * fast_sigmoid(1.5957691216057308f * (x + 0.044715f * x * x * x)); }
__device__ __forceinline__ void ssm_unit(Frame& F, const unsigned char* tab, const float* SIN, int b, int c) {
    LAS unsigned char* L = (LAS unsigned char*)F.lds;
    const int lane = F.lane, wid = F.wave, cc = lane & 31, h = lane >> 5, t0 = b * SEQ + c * CHK;
    LAS unsigned char* sst = L + SST_OFF + wid * 8192;
    LAS bf16* ZT = (LAS bf16*)(L + ZT_OFF);
    struct GPre { f32x2v aA, aB, sA, sB; bf16x8 Bb[4], Au[2]; };
    auto gload = [&](int g, GPre& P) {
        P.aA = ((const f32x2v*)(tab + TAB_A))[g * NST + cc]; P.aB = ((const f32x2v*)(tab + TAB_A))[g * NST + 32 + cc];
#pragma unroll
        for (int st = 0; st < 4; ++st) P.Bb[st] = ((const bf16x8*)(tab + TAB_BB))[(g * 4 + st) * 64 + lane];
        const bf16* ub = F.U + ((size_t)g * T + t0) * SGC;
#pragma unroll
        for (int pt = 0; pt < 2; ++pt) { const int i = lane & 31, pos = 32 * ((i >> 2) & 1) + 16 * pt + (i & 3) + 4 * (i >> 3); P.Au[pt] = *(const bf16x8*)(ub + pos * SGC + 8 * (lane >> 5)); }
        const float* sinp = SIN + ((((size_t)b * NCH + c) * NGR + g) * 2 + h) * 128;
        P.sA = *(const f32x2v*)(sinp + 2 * cc); P.sB = *(const f32x2v*)(sinp + 2 * (32 + cc));
    };
    GPre cur; gload(wid * 4, cur);
#pragma unroll 1
    for (int gi = 0; gi < 4; ++gi) {
        const int g = wid * 4 + gi;
        GPre nxt; gload(wid * 4 + (gi < 3 ? gi + 1 : gi), nxt);
        const f32x2v aA = cur.aA, aB = cur.aB;
        bf16x8 Cm[5];
#pragma unroll
        for (int ks = 0; ks < 5; ++ks) Cm[ks] = ((const bf16x8*)(tab + TAB_CM))[(g * 5 + ks) * 64 + lane];
        const bf16* ubase = F.U + ((size_t)g * T + t0) * SGC;
        f32x16 bu[2][4];
#pragma unroll
        for (int pt = 0; pt < 2; ++pt) {
#pragma unroll
            for (int st = 0; st < 4; ++st) { f32x16 z;
#pragma unroll
                for (int r = 0; r < 16; ++r) z[r] = 0.f;
                bu[pt][st] = __builtin_amdgcn_mfma_f32_32x32x16_bf16(cur.Au[pt], cur.Bb[st], z, 0, 0, 0); } }
        f32x2v sA = cur.sA, sB = cur.sB;
#pragma unroll
        for (int pt = 0; pt < 2; ++pt) {
#pragma unroll
            for (int r = 0; r < 16; ++r) {
                sA = (f32x2v){aA.x * sA.x - aA.y * sA.y + bu[pt][0][r], aA.x * sA.y + aA.y * sA.x + bu[pt][1][r]};
                sB = (f32x2v){aB.x * sB.x - aB.y * sB.y + bu[pt][2][r], aB.x * sB.y + aB.y * sB.x + bu[pt][3][r]};
                const int R = 16 * h + r;
                *(LAS unsigned*)(sst + R * 256 + ((((cc >> 2) ^ r) << 2) | (cc & 3)) * 4) = pg::cvt_pk_bf16(sA.x, sA.y);
                *(LAS unsigned*)(sst + R * 256 + ((((8 + (cc >> 2)) ^ r) << 2) | (cc & 3)) * 4) = pg::cvt_pk_bf16(sB.x, sB.y);
            }
#pragma unroll
            for (int rb = 0; rb < 2; ++rb) { const int Rr = 16 * rb + (lane & 15); f32x4 y = (f32x4){0.f, 0.f, 0.f, 0.f};
#pragma unroll
                for (int ks = 0; ks < 4; ++ks) { const bf16x8 As = *(const LAS bf16x8*)(sst + Rr * 256 + ((((lane >> 4) + 4 * ks) ^ (lane & 15)) << 4));
                    y = __builtin_amdgcn_mfma_f32_16x16x32_bf16(As, Cm[ks], y, 0, 0, 0); }
                { const int posr = 32 * rb + 16 * pt + (lane & 15); bf16x8 A5 = (bf16x8){0, 0, 0, 0, 0, 0, 0, 0};
                  if ((lane >> 4) < 2) A5 = *(const bf16x8*)(ubase + posr * SGC + 8 * (lane >> 4));
                  y = __builtin_amdgcn_mfma_f32_16x16x32_bf16(A5, Cm[4], y, 0, 0, 0); }
#pragma unroll
                for (int i = 0; i < 4; ++i) { const int pos = 32 * rb + 16 * pt + 4 * (lane >> 4) + i; ZT[pos * DS + g * SGC + (lane & 15)] = (bf16)f2bf(gelu_fast(y[i])); }
            }
        }
        cur = nxt;
    }
    __syncthreads();
#pragma unroll
    for (int i = 0; i < 8; ++i) { const int idx = F.tid + NTHR * i, row = idx >> 6, c16 = idx & 63; *(v4u*)(F.Z + (size_t)(t0 + row) * DS + c16 * 8) = *(const LAS v4u*)(ZT + row * DS + c16 * 8); }
    __syncthreads();
}
__device__ __forceinline__ void ssm_phase(Frame& F, const unsigned char* ws) {
#pragma unroll 1
    for (int u = F.vcu; u < NB * NCH; u += F.G) ssm_unit(F, ws + OFF_TAB, (const float*)(ws + OFF_SIN), u / NCH, u % NCH);
}
}

namespace rt {
typedef float f32x16 __attribute__((ext_vector_type(16)));
constexpr int WT_OFF = 0, LG_OFF = 81920, SS_OFF = 114688, HIST_OFF = 115712, BASE_OFF = 115840;
__device__ __forceinline__ void route_phase(Frame& F) {
    LAS unsigned char* L = (LAS unsigned char*)F.lds;
    LAS bf16* Wh = (LAS bf16*)(L + WT_OFF);
    LAS bf16* Wl = Wh + 20 * DM;
    LAS float* LG = (LAS float*)(L + LG_OFF);
    LAS float* SS = (LAS float*)(L + SS_OFF);
    LAS unsigned* hist = (LAS unsigned*)(L + HIST_OFF); LAS unsigned* base = (LAS unsigned*)(L + BASE_OFF);
    const int tid = F.tid, lane = F.lane, wid = F.wave;
    if (F.vcu * 128 >= T) return;
    for (int k = tid; k < DM; k += NTHR) { const float g = F.gain2[k]; const f32x4 a = *(const f32x4*)(F.w_gr + k * 4);
        const f32x4 e0 = *(const f32x4*)(F.w_er + k * 16), e1 = *(const f32x4*)(F.w_er + k * 16 + 4), e2 = *(const f32x4*)(F.w_er + k * 16 + 8), e3 = *(const f32x4*)(F.w_er + k * 16 + 12);
#pragma unroll
        for (int o = 0; o < 4; ++o) { const float w5[5] = {a[o] * g, e0[o] * g, e1[o] * g, e2[o] * g, e3[o] * g};
#pragma unroll
            for (int q = 0; q < 5; ++q) { const int oo = 4 * q + o; const unsigned hb = f2bf(w5[q]); Wh[oo * DM + k] = (bf16)hb; Wl[oo * DM + k] = (bf16)f2bf(w5[q] - bf2f(hb)); } } }
    if (tid < 32) hist[tid] = 0u;
    __syncthreads();
    const int tb = wid >> 1, kh = wid & 1, i = lane & 31, h = lane >> 5;
#pragma unroll 1
    for (int it = F.vcu; it * 128 < T; it += F.G) {
        const int t0 = it * 128;
        { const bf16* xp = F.XB + (size_t)(t0 + 32 * tb + i) * DM + 512 * kh + 8 * h;
          const LAS bf16* whp = Wh + (i < 20 ? i : 0) * DM + 512 * kh + 8 * h; const LAS bf16* wlp = Wl + (i < 20 ? i : 0) * DM + 512 * kh + 8 * h;
          f32x16 acc;
#pragma unroll
          for (int r = 0; r < 16; ++r) acc[r] = 0.f;
          float ss = 0.f;
#pragma unroll 8
          for (int q = 0; q < 32; ++q) { const pg::u32x4 xw = *(const pg::u32x4*)(xp + 16 * q); f32x4 x0, x1; unpack8(xw, x0, x1);
              ss += ((x0[0] * x0[0] + x0[1] * x0[1]) + (x0[2] * x0[2] + x0[3] * x0[3])) + ((x1[0] * x1[0] + x1[1] * x1[1]) + (x1[2] * x1[2] + x1[3] * x1[3]));
              const pg::bf16x8 xa = __builtin_bit_cast(pg::bf16x8, xw), bh = *(const LAS pg::bf16x8*)(whp + 16 * q), bl = *(const LAS pg::bf16x8*)(wlp + 16 * q);
              acc = __builtin_amdgcn_mfma_f32_32x32x16_bf16(xa, bh, acc, 0, 0, 0); acc = __builtin_amdgcn_mfma_f32_32x32x16_bf16(xa, bl, acc, 0, 0, 0); }
          ss += __shfl_xor(ss, 32);
          if (h == 0) SS[(32 * tb + i) * 2 + kh] = ss;
#pragma unroll
          for (int r = 0; r < 16; ++r) { const int row = (r & 3) + 8 * (r >> 2) + 4 * h; LG[((32 * tb + row) * 2 + kh) * 32 + i] = acc[r]; } }
        __syncthreads();
        int cls = 0; unsigned lrank = 0; float wlo = 0.f, whi = 0.f, rs = 0.f;
        if (tid < 128) {
            float lg[20];
#pragma unroll
            for (int o = 0; o < 20; ++o) lg[o] = LG[(tid * 2) * 32 + o] + LG[(tid * 2 + 1) * 32 + o];
            rs = 1.0f / sqrtf((SS[tid * 2] + SS[tid * 2 + 1]) * (1.0f / DM) + EPS);
            float g4[4]; int gi = 0;
#pragma unroll
            for (int j = 0; j < 4; ++j) g4[j] = lg[j] * rs + F.b_gr[j];
#pragma unroll
            for (int j = 1; j < 4; ++j) if (g4[j] > g4[gi]) gi = j;
            float gs = 0.f;
#pragma unroll
            for (int j = 0; j < 4; ++j) gs += expf(g4[j] - g4[gi]);
            const float gp = 1.0f / gs;
            float le[4];
#pragma unroll
            for (int j = 0; j < 4; ++j) { float a = 0.f;
#pragma unroll
                for (int q = 0; q < 4; ++q) a = (gi == q) ? lg[4 + 4 * q + j] : a;
                le[j] = a * rs + F.b_er[gi * 4 + j]; }
            int e1 = 0;
#pragma unroll
            for (int j = 1; j < 4; ++j) if (le[j] > le[e1]) e1 = j;
            int e2 = (e1 == 0) ? 1 : 0;
#pragma unroll
            for (int j = 0; j < 4; ++j) if (j != e1 && le[j] > le[e2]) e2 = j;
            const float p2 = expf(le[e2] - le[e1]);
            const float w1 = gp / (1.0f + p2), w2 = gp * p2 / (1.0f + p2);
            const int lo = e1 < e2 ? e1 : e2, hi2 = e1 < e2 ? e2 : e1;
            wlo = e1 < e2 ? w1 : w2; whi = e1 < e2 ? w2 : w1;
            cls = gi * 6 + pair_index(lo, hi2);
            lrank = __hip_atomic_fetch_add(hist + cls, 1u, __ATOMIC_RELAXED, __HIP_MEMORY_SCOPE_WORKGROUP);
        }
        __syncthreads();
        if (tid < NCLS) { const unsigned n = hist[tid]; base[tid] = n ? xb_add(F.ctl + CW_CNT + 64 * tid, n) : 0u; hist[tid] = 0u; }
        __syncthreads();
        if (tid < 128) { const int t = t0 + tid; const unsigned rank = base[cls] + lrank;
            F.LIST[(size_t)cls * T + rank] = t; F.TOKC[t] = cls; F.TOKW[2 * t] = wlo; F.TOKW[2 * t + 1] = whi; F.RSTD2[t] = rs; }
        __syncthreads();
    }
}
}

__global__ void __launch_bounds__(NTHR, 2) mk_fwd(Args args) {
    extern __shared__ __attribute__((aligned(16))) unsigned char lds[];
    Frame F;
    F.lds = lds; F.tid = threadIdx.x; F.lane = F.tid & 63; F.wave = __builtin_amdgcn_readfirstlane(F.tid >> 6);
    F.G = gridDim.x; { const int bx = blockIdx.x; F.vcu = (F.G % 8 == 0) ? (bx % 8) * (F.G / 8) + bx / 8 : bx; }
    unsigned char* ws = args.ws;
    F.x = args.in[0]; F.gain1 = args.in[1]; F.w_in = args.in[2]; F.b_gate = args.in[3]; F.q_gain = args.in[4]; F.k_gain = args.in[5]; F.rel_bias = args.in[6];
    F.lam_re = args.in[7]; F.lam_im = args.in[8]; F.log_step = args.in[9]; F.sb_re = args.in[10]; F.sb_im = args.in[11]; F.sc_re = args.in[12]; F.sc_im = args.in[13];
    F.ssm_d = args.in[14]; F.w_glu = args.in[15]; F.b_glu = args.in[16]; F.w_branch = args.in[17]; F.w_out = args.in[18]; F.gain2 = args.in[19];
    F.w_gr = args.in[20]; F.b_gr = args.in[21]; F.w_er = args.in[22]; F.b_er = args.in[23]; F.w_eg = args.in[24]; F.w_eu = args.in[25]; F.w_ed = args.in[26];
    F.out = args.out; F.ctl = (unsigned*)(ws + OFF_CTL);
    F.XB = (bf16*)(ws + OFF_XB); F.Q = (bf16*)(ws + OFF_Q); F.K = (bf16*)(ws + OFF_K); F.V = (bf16*)(ws + OFF_V); F.U = (bf16*)(ws + OFF_U); F.GT = (bf16*)(ws + OFF_G);
    F.YA = (bf16*)(ws + OFF_YA); F.Z = (bf16*)(ws + OFF_Z); F.YS = (bf16*)(ws + OFF_YS); F.MG = (bf16*)(ws + OFF_MERGED); F.HID = (bf16*)(ws + OFF_HID);
    F.LIST = (int*)(ws + OFF_LIST); F.TOKC = (int*)(ws + OFF_TOKC); F.TOKW = (float*)(ws + OFF_TOKW); F.RSTD1 = (float*)(ws + OFF_RSTD1); F.RSTD2 = (float*)(ws + OFF_RSTD2);
    for (int u = F.tid; u < (LDS_BYTES - LDSCTL_OFF) / 4; u += NTHR) ((LAS unsigned*)((LAS unsigned char*)lds + LDSCTL_OFF))[u] = 0u;
    __syncthreads();
    XcdBarrier bar = xcd_barrier_post(F.ctl + CW_BAR, (volatile LAS unsigned*)((LAS unsigned char*)lds + MISC_OFF) + 8);
    const int lo = args.ph_lo, hi = args.ph_hi;
#define IN(k) (lo <= (k) && (k) < hi)
#define SEAM(k) do { if (IN(k) && IN((k) + 1)) xcd_barrier(bar); } while (0)
    if (IN(0)) {
    if (F.wave < 4) ph_xconv(F, 4);
    else { ph_weights(F, ws, true, F.vcu, F.G, 4, 4); ph_ssmtab(F, ws, 256); }
    }
    SEAM(0);
    if (IN(1)) {
    { SchedPlain S; S.o.init(T, DIN, F.G, (int)blockIdx.x); S.A = (const char*)F.XB; S.B = (const char*)(ws + OFF_WIN); S.lda_b = DM * 2; S.ldb_b = DM * 2; S.nseg = 1; S.segA = 0; S.segB = 0; S.khalf_b = DM;
      EpiInproj E{F.Q, F.K, F.V, F.U, F.GT, F.RSTD1, F.q_gain, F.k_gain, F.b_gate};
      pg::gemm_phase<EpiInproj, SchedPlain, false>((LAS unsigned char*)lds, DM, DM * 2, DM * 2, S, E); }
    }
    SEAM(1);
    if (IN(2)) {
    { SchedSloc S; S.U = (const char*)F.U; S.W = (const char*)(ws + OFF_WSSM); S.c = (int)blockIdx.x;
      EpiSloc E{(float*)(ws + OFF_SIN), (const f32x2v*)(ws + OFF_TAB + TAB_A32), (const f32x2v*)(ws + OFF_TAB + TAB_A64)};
      pg::gemm_phase<EpiSloc, SchedSloc, false>((LAS unsigned char*)lds, 1024, 2048, 2048, S, E);
      __syncthreads(); }
    att::attn_phase(F);
    ph_weights(F, ws, false, F.vcu, F.G); __syncthreads();
    }
    SEAM(2);
    if (IN(3)) {
    ssm::ssm_phase(F, ws);
    }
    SEAM(3);
    if (IN(4)) {
    { SchedPlain S; S.o.init(T, DS, F.G, (int)blockIdx.x); S.A = (const char*)F.Z; S.B = (const char*)(ws + OFF_WGLU); S.lda_b = DS * 2; S.ldb_b = DS * 2; S.nseg = 1; S.segA = 0; S.segB = 0; S.khalf_b = DS;
      EpiGlu E{F.Z, F.YS, F.b_glu};
      pg::gemm_phase<EpiGlu, SchedPlain, false>((LAS unsigned char*)lds, DS, DS * 2, DS * 2, S, E); }
    }
    SEAM(4);
    if (IN(5)) {
    { SchedPlain S; S.o.init(T, DM, F.G, (int)blockIdx.x); S.A = (const char*)F.YA; S.B = (const char*)(ws + OFF_WA); S.lda_b = DA * 2; S.ldb_b = DA * 2; S.nseg = 2; S.khalf_b = DA;
      S.segA = (size_t)((const char*)F.YS - (const char*)F.YA); S.segB = OFF_WS - OFF_WA;
      EpiBranch E{(const unsigned char*)F.GT, F.MG};
      pg::gemm_phase<EpiBranch, SchedPlain, false>((LAS unsigned char*)lds, DA, DA * 2, DA * 2, S, E); }
    }
    SEAM(5);
    if (IN(6)) {
    { SchedPlain S; S.o.init(T, DM, F.G, (int)blockIdx.x); S.A = (const char*)F.MG; S.B = (const char*)(ws + OFF_WOUT); S.lda_b = DM * 2; S.ldb_b = DM * 2; S.nseg = 1; S.segA = 0; S.segB = 0; S.khalf_b = DM;
      EpiOut E{F.XB};
      pg::gemm_phase<EpiOut, SchedPlain, false>((LAS unsigned char*)lds, DM, DM * 2, DM * 2, S, E); }
    }
    SEAM(6);
    if (IN(7)) {
    rt::route_phase(F);
    }
    SEAM(7);
    if (IN(8)) {
    { moe_build_tab(F);
      SchedMoe S; S.tab = (const LAS int*)((LAS unsigned char*)lds + MOE_TAB_OFF); S.G = F.G; S.c = (int)blockIdx.x; S.nseg = 1; S.mode = 0; S.A = (const char*)F.XB; S.B = (const char*)(ws + OFF_WGU); S.LIST = F.LIST;
      EpiGateUp E{F.HID, F.RSTD2, F.TOKW};
      pg::gemm_phase<EpiGateUp, SchedMoe, true>((LAS unsigned char*)lds, DM, DM * 2, DM * 2, S, E); }
    }
    SEAM(8);
    if (IN(9)) {
    { moe_build_tab(F);
      SchedMoe S; S.tab = (const LAS int*)((LAS unsigned char*)lds + MOE_TAB_OFF); S.G = F.G; S.c = (int)blockIdx.x; S.nseg = 1; S.mode = 1; S.A = (const char*)F.HID; S.B = (const char*)(ws + OFF_WD); S.LIST = F.LIST;
      EpiDown E{F.out, F.XB};
      pg::gemm_phase<EpiDown, SchedMoe, true, true>((LAS unsigned char*)lds, 2 * DEX, 512 * 2, DEX * 2, S, E); }
    }
#undef IN
#undef SEAM
}

extern "C" void kernel_launch(void* const* d_in, const int* in_sizes, int n_in, void* d_out, int out_size, void* d_ws, size_t ws_size, hipStream_t stream) {
    static int grid = 0;
    if (grid == 0) {
        if (n_in != 27 || in_sizes[0] != T * DM || out_size != T * DM || ws_size < WS_END) { fprintf(stderr, "kernel_launch: unexpected shapes (n_in %d, in0 %d, out %d, ws %zu)\n", n_in, n_in > 0 ? in_sizes[0] : -1, out_size, ws_size); grid = -1; return; }
        int dev = 0, cus = 0;
        if (hipGetDevice(&dev) != hipSuccess || hipDeviceGetAttribute(&cus, hipDeviceAttributeMultiprocessorCount, dev) != hipSuccess) { grid = -1; return; }
        if (hipFuncSetAttribute((const void*)mk_fwd, hipFuncAttributeMaxDynamicSharedMemorySize, LDS_BYTES) != hipSuccess) { fprintf(stderr, "kernel_launch: hipFuncSetAttribute failed\n"); grid = -1; return; }
        int per_cu = 0;
        if (hipOccupancyMaxActiveBlocksPerMultiprocessor(&per_cu, (const void*)mk_fwd, NTHR, LDS_BYTES) != hipSuccess || per_cu < 1) fprintf(stderr, "kernel_launch: occupancy query reports %d\n", per_cu);
        (void)hipGetLastError();
        grid = cus;
    }
    if (grid < 0) return;
    (void)hipMemsetAsync((char*)d_ws + OFF_CTL, 0, CTL_ZERO_BYTES, stream);
    Args a{};
    for (int i = 0; i < 27; ++i) a.in[i] = (const float*)d_in[i];
    a.out = (float*)d_out; a.ws = (unsigned char*)d_ws; a.ph_lo = 0; a.ph_hi = 10;
    hipLaunchKernelGGL(mk_fwd, dim3(grid), dim3(NTHR), LDS_BYTES, stream, a);
}
```

```cpp
#include <hip/hip_runtime.h>
#include <cstdio>
#include <cstdint>
#include <cmath>

constexpr int DM = 1024, NB = 16, SEQ = 2048, T = NB * SEQ, CHK = 64, NCH = SEQ / CHK, NH = 8, HD = 64, DA = 512, DS = 512;
constexpr int SGC = 16, NGR = 32, NST = 64, DIN = 4096, NEX = 16, DEX = 256, NREL = 320, LEFT = 8, NCLS = 24;
constexpr float EPS = 1e-6f;
constexpr float LOG2E = 1.4426950408889634f;
constexpr float QSCALE = 0.125f * LOG2E;
constexpr int NWAVES = 8, NTHR = 512;

constexpr size_t MiB = 1u << 20;
constexpr size_t OFF_CTL = 0, CTL_ZERO_BYTES = 1 * MiB;
constexpr size_t OFF_TAB = 1 * MiB;
constexpr size_t OFF_LIST = 56 * MiB;
constexpr size_t OFF_TOKC = 59 * MiB;
constexpr size_t OFF_TOKW = OFF_TOKC + 128 * 1024;
constexpr size_t OFF_RSTD1 = OFF_TOKW + 256 * 1024;
constexpr size_t OFF_RSTD2 = OFF_RSTD1 + 128 * 1024;
constexpr size_t OFF_XB = 64 * MiB;
constexpr size_t OFF_Q = 128 * MiB, OFF_K = 160 * MiB, OFF_V = 192 * MiB, OFF_U = 224 * MiB;
constexpr size_t OFF_G = 256 * MiB;
constexpr size_t OFF_YA = 416 * MiB, OFF_Z = 448 * MiB;
constexpr size_t OFF_YS = OFF_U, OFF_MERGED = OFF_Q, OFF_HID = OFF_V;
constexpr size_t WS_END = 480 * MiB;
constexpr int CW_CNT = 1024;
constexpr int CW_BAR = 4096;
constexpr int CW_ATTQ = 3072;

constexpr int LDS_BYTES = 147456, LDSCTL_OFF = 131072, MISC_OFF = LDSCTL_OFF + 320;

#define GAS __attribute__((address_space(1)))
#define LAS __attribute__((address_space(3)))
typedef unsigned short bf16;
typedef unsigned v4u __attribute__((ext_vector_type(4)));
typedef float f32x4 __attribute__((ext_vector_type(4)));

__device__ __forceinline__ unsigned f2bf(float f) { unsigned u = __builtin_bit_cast(unsigned, f); return (u + 0x7fffu + ((u >> 16) & 1u)) >> 16; }
__device__ __forceinline__ float bf2f(unsigned b) { return __builtin_bit_cast(float, (b & 0xffffu) << 16); }
__device__ __forceinline__ float bflo(unsigned w) { return __builtin_bit_cast(float, w << 16); }
__device__ __forceinline__ float bfhi(unsigned w) { return __builtin_bit_cast(float, w & 0xffff0000u); }
__device__ __forceinline__ unsigned pk2(float lo, float hi) { return f2bf(lo) | (f2bf(hi) << 16); }
__device__ __forceinline__ float wave_sum(float v) {
#pragma unroll
    for (int o = 1; o < 64; o <<= 1) v += __shfl_xor(v, o);
    return v;
}
__device__ __forceinline__ float sigmoidf_(float x) { return 1.0f / (1.0f + __expf(-x)); }
__device__ __forceinline__ float gelu_tanh(float x) { const float u = 0.7978845608028654f * (x + 0.044715f * x * x * x); return 0.5f * x * (1.0f + tanhf(u)); }

#define XB_TMO      128
#define XB_XCNT(j)  (256  + 64 * (j))
#define XB_XSUB(j)  (1280 + 64 * (j))
#define XB_XGEN(j)  (2304 + 64 * (j))
#define XB_TOP      3328
#define XB_TOPGEN   3392
#define XCD_BAR_WORDS 3456
#define XB_SPIN_CAP (1u << 22)
__device__ __forceinline__ unsigned xb_ld(unsigned* p)              { return __hip_atomic_load(p, __ATOMIC_RELAXED, __HIP_MEMORY_SCOPE_AGENT); }
__device__ __forceinline__ unsigned xb_add(unsigned* p, unsigned v) { return __hip_atomic_fetch_add(p, v, __ATOMIC_RELAXED, __HIP_MEMORY_SCOPE_AGENT); }
__device__ __forceinline__ unsigned xb_xcc_id() { return (unsigned)__builtin_amdgcn_s_getreg((3 << 11) | 20) & 0xFu; }
#define XB_SPIN(cond, bar) do { unsigned _sp = 0; while (cond) { __builtin_amdgcn_s_sleep(1); \
    if ((++_sp & 255u) == 0u) { if (xb_ld(&(bar)[XB_TMO])) break; if (_sp > XB_SPIN_CAP) { atomicAdd(&(bar)[XB_TMO], 1u); break; } } } } while (0)
struct XcdBarrier { unsigned* bar; unsigned x; volatile LAS unsigned* st; };
__device__ __forceinline__ XcdBarrier xcd_barrier_post(unsigned* bar, volatile LAS unsigned* st) {
    XcdBarrier b; b.bar = bar; b.x = xb_xcc_id(); b.st = st;
    if (threadIdx.x == 0) (void)xb_add(&bar[XB_XCNT(b.x)], 1u);
    return b;
}
__device__ __forceinline__ void xcd_barrier_complete(unsigned* bar, unsigned x, unsigned& nloc, unsigned& nx) {
    const unsigned G = gridDim.x * gridDim.y * gridDim.z;
    unsigned sum, cnt, mine, sp = 0u;
    for (;;) {
        sum = 0u; cnt = 0u; mine = 0u;
#pragma unroll
        for (unsigned j = 0; j < 16; ++j) { const unsigned c = xb_ld(&bar[XB_XCNT(j)]); sum += c; cnt += (c > 0u) ? 1u : 0u; mine = (j == x) ? c : mine; }
        if (sum == G) break;
        __builtin_amdgcn_s_sleep(1);
        if ((++sp & 255u) == 0u) { if (xb_ld(&bar[XB_TMO])) break; if (sp > XB_SPIN_CAP) { atomicAdd(&bar[XB_TMO], 1u); break; } }
    }
    nloc = mine > 0u ? mine : 1u; nx = cnt > 0u ? cnt : 1u;
}
__device__ __forceinline__ void xcd_barrier(const XcdBarrier& b) {
    asm volatile("s_waitcnt vmcnt(0)" ::: "memory");
    __syncthreads();
    if (threadIdx.x == 0) {
        unsigned* bar = b.bar;
        __builtin_amdgcn_s_waitcnt(0);
        unsigned nloc = b.st[0], nx = b.st[1];
        if (nloc == 0u) { xcd_barrier_complete(bar, b.x, nloc, nx); b.st[0] = nloc; b.st[1] = nx; }
        const unsigned old = xb_add(&bar[XB_XSUB(b.x)], 1u);
        const unsigned gen = old / nloc;
        if (old + 1u == (gen + 1u) * nloc) {
            __builtin_amdgcn_fence(__ATOMIC_RELEASE, "agent");
            asm volatile("s_waitcnt vmcnt(0)" ::: "memory");
            const unsigned og = xb_add(&bar[XB_TOP], 1u);
            const unsigned tg = og / nx;
            if (og + 1u == (tg + 1u) * nx) xb_add(&bar[XB_TOPGEN], 1u);
            else XB_SPIN(xb_ld(&bar[XB_TOPGEN]) == tg, bar);
            __builtin_amdgcn_fence(__ATOMIC_ACQUIRE, "agent");
            xb_add(&bar[XB_XGEN(b.x)], 1u);
            asm volatile("s_waitcnt vmcnt(0)" ::: "memory");
        } else {
            __builtin_amdgcn_fence(__ATOMIC_ACQUIRE, "agent");
            XB_SPIN(xb_ld(&bar[XB_XGEN(b.x)]) == gen, bar);
            asm volatile("s_waitcnt vmcnt(0)" ::: "memory");
        }
    }
    __syncthreads();
}

struct Args { const float* in[27]; float* out; unsigned char* ws; int ph_lo, ph_hi; };
struct Frame {
    unsigned char* lds; int tid, lane, wave, vcu, G;
    const float* x; const float* gain1; const float* w_in; const float* b_gate; const float* q_gain; const float* k_gain; const float* rel_bias;
    const float *lam_re, *lam_im, *log_step, *sb_re, *sb_im, *sc_re, *sc_im, *ssm_d, *w_glu, *b_glu, *w_branch, *w_out, *gain2, *w_gr, *b_gr, *w_er, *b_er, *w_eg, *w_eu, *w_ed;
    float* out; unsigned* ctl;
    bf16 *XB, *Q, *K, *V, *U, *GT, *YA, *Z, *YS, *MG, *HID;
    int* LIST; int* TOKC; float* TOKW; float* RSTD1; float* RSTD2;
};

__device__ __forceinline__ float dpp_sum16(float v) {
    v += __builtin_bit_cast(float, __builtin_amdgcn_mov_dpp(__builtin_bit_cast(int, v), 0xB1, 0xF, 0xF, true));
    v += __builtin_bit_cast(float, __builtin_amdgcn_mov_dpp(__builtin_bit_cast(int, v), 0x4E, 0xF, 0xF, true));
    v += __builtin_bit_cast(float, __builtin_amdgcn_mov_dpp(__builtin_bit_cast(int, v), 0x141, 0xF, 0xF, true));
    v += __builtin_bit_cast(float, __builtin_amdgcn_mov_dpp(__builtin_bit_cast(int, v), 0x140, 0xF, 0xF, true));
    return v;
}
__device__ __forceinline__ void ph_xconv(Frame& F, int nwv) {
    const int gw = F.vcu * nwv + F.wave, NGW = F.G * nwv, lr = F.lane & 15, rsub = F.lane >> 4;
    f32x4 a[8], b[8];
    int m4 = gw;
    if (m4 < T / 4) { const f32x4* xr = (const f32x4*)(F.x + (size_t)(m4 * 4 + rsub) * DM + 8 * lr);
#pragma unroll
        for (int j = 0; j < 8; ++j) { a[j] = __builtin_nontemporal_load(xr + 32 * j); b[j] = __builtin_nontemporal_load(xr + 32 * j + 1); } }
    for (; m4 < T / 4; m4 += NGW) {
        const int m = m4 * 4 + rsub, mn4 = m4 + NGW;
        f32x4 a2[8], b2[8];
        if (mn4 < T / 4) { const f32x4* xr = (const f32x4*)(F.x + (size_t)(mn4 * 4 + rsub) * DM + 8 * lr);
#pragma unroll
            for (int j = 0; j < 8; ++j) { a2[j] = __builtin_nontemporal_load(xr + 32 * j); b2[j] = __builtin_nontemporal_load(xr + 32 * j + 1); } }
        float s = 0.f;
#pragma unroll
        for (int j = 0; j < 8; ++j) s += ((a[j].x * a[j].x + a[j].y * a[j].y) + (a[j].z * a[j].z + a[j].w * a[j].w)) + ((b[j].x * b[j].x + b[j].y * b[j].y) + (b[j].z * b[j].z + b[j].w * b[j].w));
        s = dpp_sum16(s);
        if (lr == 0) F.RSTD1[m] = 1.0f / sqrtf(s * (1.0f / DM) + EPS);
        v4u* o = (v4u*)(F.XB + (size_t)m * DM + 8 * lr);
#pragma unroll
        for (int j = 0; j < 8; ++j) o[16 * j] = (v4u){pk2(a[j].x, a[j].y), pk2(a[j].z, a[j].w), pk2(b[j].x, b[j].y), pk2(b[j].z, b[j].w)};
        if (mn4 < T / 4) {
#pragma unroll
            for (int j = 0; j < 8; ++j) { a[j] = a2[j]; b[j] = b2[j]; } }
    }
}

__device__ __forceinline__ int pair_index(int lo, int hi) { return lo == 0 ? hi - 1 : (lo == 1 ? hi + 1 : 5); }
__device__ __forceinline__ void pair_decode(int pr, int& lo, int& hi) { lo = pr < 3 ? 0 : (pr < 5 ? 1 : 2); hi = pr < 3 ? pr + 1 : (pr < 5 ? pr - 1 : 3); }
namespace pg {
typedef short bf16x8 __attribute__((ext_vector_type(8)));
typedef unsigned u32x4 __attribute__((ext_vector_type(4)));
typedef unsigned u32x2 __attribute__((ext_vector_type(2)));
typedef float f32x2 __attribute__((ext_vector_type(2)));
constexpr int BM = 256, BK = 64, HALF = 128, HTB = HALF * BK * 2, STAGE_BYTES = 8 * HTB, NXCD = 8, WGM = 8;
__host__ __device__ __forceinline__ int lds_byte(int r, int c) { const int st = (r >> 4) * 2 + (c >> 5), rr = r & 15, cc = c & 31, ob = rr * 64 + cc * 2; return st * 1024 + (ob ^ (((ob >> 9) & 1) << 5)); }
__host__ __device__ __forceinline__ void stage_rc(int b, int& R, int& C) { const int st = b / 1024, sb = b % 1024, swz = sb ^ (((sb >> 9) & 1) << 5); R = (st >> 1) * 16 + swz / 64; C = (st & 1) * 32 + (swz % 64) / 2; }
__host__ __device__ __forceinline__ int perm32(int rho) { const int n = rho >> 4, i = rho & 15; return 8 * (i >> 2) + 4 * n + (i & 3); }
typedef __bf16 bf16x2_t __attribute__((ext_vector_type(2)));
__device__ __forceinline__ unsigned cvt_pk_bf16(float lo, float hi) { f32x2 v = {lo, hi}; bf16x2_t b = __builtin_convertvector(v, bf16x2_t); return __builtin_bit_cast(unsigned, b); }

enum { UF_FIRST = 1, UF_LAST = 2 };
struct Unit { const char* A; const char* B; const int* list; int pm, pn, flags, cnt, aux; };

struct TileOrder {
    int nM, nN, nwg, G, c;
    __device__ __forceinline__ void init(int M, int N, int G_, int c_) { nM = M / BM; nN = N / BM; nwg = nM * nN; G = G_; c = c_; }
    __device__ __forceinline__ bool tile(int i, int& pm, int& pn) const {
        const long L = (long)i * G + c; if (L >= nwg) return false;
        int wgid = (int)L; { const int q = nwg / NXCD, r = nwg % NXCD, xcd = wgid % NXCD, off = wgid / NXCD; wgid = (xcd < r ? xcd * (q + 1) : r * (q + 1) + (xcd - r) * q) + off; }
        const int nig = WGM * nN, gid = wgid / nig, fm = gid * WGM, gsz = (nM - fm) < WGM ? (nM - fm) : WGM;
        pm = fm + ((wgid % nig) % gsz); pn = (wgid % nig) / gsz; return true;
    }
};

typedef f32x4 Acc[2][2][4][2];
template <class Epi, class Sched, bool GATHER, bool BSPLIT = false>
__device__ __forceinline__ void gemm_phase(LAS unsigned char* lds, const int K, const int lda_b, const int ldb_b, const Sched& S, const Epi& E) {
    const int tid = threadIdx.x, wid = __builtin_amdgcn_readfirstlane(tid >> 6), lane = tid & 63, wr = wid >> 2, wc = wid & 3, fr = lane & 15, fq = lane >> 4;
    const int nt = K / BK;
    unsigned voffB[2], oA[2][2], noA[2][2]; int RA[2], CA[2];
#pragma unroll
    for (int i = 0; i < 2; ++i) { int R, C; stage_rc(tid * 16 + i * 8192, R, C); const int Rb = Epi::PERM ? ((R & ~31) + perm32(R & 31)) : R;
        RA[i] = R; CA[i] = C; voffB[i] = (unsigned)(Rb * ldb_b + C * 2);
        oA[0][i] = (unsigned)(R * lda_b + C * 2); oA[1][i] = (unsigned)((R + HALF) * lda_b + C * 2); noA[0][i] = oA[0][i]; noA[1][i] = oA[1][i]; }
    const size_t kstep = (size_t)(BK * 2);
    const size_t hstepB = (size_t)HALF * ldb_b;
    const unsigned ldsw = (unsigned)wid * 1024u;
    const int aoff = lds_byte(wr * 64 + fr, fq * 8), boff = lds_byte(wc * 32 + fr, fq * 8);
#define PG_SA(b, h) (((b) * 2 + (h)) * HTB)
#define PG_SB(b, h) ((4 + (b) * 2 + (h)) * HTB)
#define PG_STAGE_B(bufoff, gbase) do { _Pragma("unroll") for (int _i = 0; _i < 2; ++_i) \
        __builtin_amdgcn_global_load_lds((const unsigned*)((const char*)(gbase) + voffB[_i]), (LAS unsigned*)(lds + (bufoff) + ldsw + _i * 8192), 16, 0, 0); } while (0)
#define PG_STAGE_A(bufoff, gbase, o0, o1) do { \
        __builtin_amdgcn_global_load_lds((const unsigned*)((const char*)(gbase) + (o0)), (LAS unsigned*)(lds + (bufoff) + ldsw), 16, 0, 0); \
        __builtin_amdgcn_global_load_lds((const unsigned*)((const char*)(gbase) + (o1)), (LAS unsigned*)(lds + (bufoff) + ldsw + 8192), 16, 0, 0); } while (0)
#define PG_LDA(dst, b, h) do { _Pragma("unroll") for (int m = 0; m < 4; ++m) _Pragma("unroll") for (int k = 0; k < 2; ++k) dst[m][k] = *(const LAS bf16x8*)(lds + PG_SA(b, h) + aoff + m * 2048 + k * 1024); } while (0)
#define PG_LDB(dst, b, h) do { _Pragma("unroll") for (int n = 0; n < 2; ++n) _Pragma("unroll") for (int k = 0; k < 2; ++k) dst[n][k] = *(const LAS bf16x8*)(lds + PG_SB(b, h) + boff + n * 2048 + k * 1024); } while (0)
#define PG_MMA(ai, bj, At, Bt) do { __builtin_amdgcn_s_setprio(1); _Pragma("unroll") for (int m = 0; m < 4; ++m) _Pragma("unroll") for (int n = 0; n < 2; ++n) _Pragma("unroll") for (int k = 0; k < 2; ++k) \
        acc[ai][bj][m][n] = __builtin_amdgcn_mfma_f32_16x16x32_bf16(Bt[n][k], At[m][k], acc[ai][bj][m][n], 0, 0, 0); __builtin_amdgcn_s_setprio(0); } while (0)
#define PG_WAIT_V(n) asm volatile("s_waitcnt vmcnt(" #n ")" ::: "memory")
#define PG_WAIT_L(n) asm volatile("s_waitcnt lgkmcnt(" #n ")" ::: "memory")
#define PG_BAR __builtin_amdgcn_s_barrier()
#define PG_SCHED __builtin_amdgcn_sched_barrier(0)
#define PG_GATHER_OFFS(dst, U) do { if constexpr (GATHER) { _Pragma("unroll") for (int _h = 0; _h < 2; ++_h) _Pragma("unroll") for (int _i = 0; _i < 2; ++_i) { \
        const int _r = _h * HALF + RA[_i]; const int _row = (U).list[_r < (U).cnt ? _r : 0]; dst[_h][_i] = (unsigned)_row * (unsigned)lda_b + (unsigned)(CA[_i] * 2); } } } while (0)
    Unit cur, nxt; int ui = 0;
    if (!S.next(0, cur)) return;
    PG_GATHER_OFFS(oA, cur);
    Acc acc;
#pragma unroll
    for (int a = 0; a < 2; ++a)
#pragma unroll
        for (int b = 0; b < 2; ++b)
#pragma unroll
            for (int m = 0; m < 4; ++m)
#pragma unroll
                for (int n = 0; n < 2; ++n) acc[a][b][m][n] = (f32x4){0.f, 0.f, 0.f, 0.f};
    bf16x8 At[4][2], B0[2][2], B1[2][2];
    const char* cA = cur.A; const char* cB = cur.B;
    PG_STAGE_B(PG_SB(0, 0), cB); PG_STAGE_B(PG_SB(0, 1), cB + hstepB); PG_STAGE_A(PG_SA(0, 0), cA, oA[0][0], oA[0][1]); PG_STAGE_A(PG_SA(0, 1), cA, oA[1][0], oA[1][1]);
    if (wr == 1) PG_BAR;
    PG_WAIT_V(2); PG_BAR;
    PG_STAGE_B(PG_SB(1, 0), cB + kstep); PG_STAGE_A(PG_SA(1, 0), cA + kstep, oA[0][0], oA[0][1]); PG_STAGE_B(PG_SB(1, 1), cB + hstepB + kstep);
    PG_WAIT_V(6); PG_BAR;
    for (;;) {
        const bool has_next = S.next(ui + 1, nxt);
        const char* nA = has_next ? nxt.A : cA; const char* nB = has_next ? nxt.B : cB;
        if constexpr (GATHER) { if (has_next) { PG_GATHER_OFFS(noA, nxt); } else {
#pragma unroll
            for (int h = 0; h < 2; ++h)
#pragma unroll
                for (int i = 0; i < 2; ++i) noA[h][i] = oA[h][i]; } }
        for (int t = 0; t < nt; t += 2) {
            const bool last = (t == nt - 2);
            const char* a1 = cA + (size_t)(t + 1) * kstep;
            const char* a2 = last ? nA : cA + (size_t)(t + 2) * kstep; const char* b2 = last ? nB : cB + (size_t)(t + 2) * kstep;
            if constexpr (BSPLIT) { if (!last && (t + 2) >= (nt >> 1)) b2 = cB + cur.aux + (size_t)(t + 2 - (nt >> 1)) * kstep; }
            const char* a3 = a2 + kstep; const char* b3 = b2 + kstep;
            unsigned q00 = oA[0][0], q01 = oA[0][1], q10 = oA[1][0], q11 = oA[1][1];
            if constexpr (GATHER) { if (last) { q00 = noA[0][0]; q01 = noA[0][1]; q10 = noA[1][0]; q11 = noA[1][1]; } }
            PG_LDB(B0, 0, 0); PG_LDB(B1, 0, 1); PG_SCHED; PG_LDA(At, 0, 0); PG_STAGE_A(PG_SA(1, 1), a1, oA[1][0], oA[1][1]);
            PG_WAIT_V(8); PG_WAIT_L(0); PG_BAR; PG_MMA(0, 0, At, B0); PG_MMA(0, 1, At, B1); PG_BAR; PG_SCHED;
            PG_LDA(At, 0, 1); PG_STAGE_B(PG_SB(0, 0), b2); PG_STAGE_B(PG_SB(0, 1), b2 + hstepB); PG_STAGE_A(PG_SA(0, 0), a2, q00, q01);
            PG_WAIT_V(8); PG_WAIT_L(0); PG_BAR; PG_MMA(1, 0, At, B0); PG_MMA(1, 1, At, B1); PG_BAR; PG_SCHED;
            PG_LDB(B0, 1, 0); PG_LDB(B1, 1, 1); PG_SCHED; PG_LDA(At, 1, 0); PG_STAGE_A(PG_SA(0, 1), a2, q10, q11);
            PG_WAIT_V(8); PG_WAIT_L(0); PG_BAR; PG_MMA(0, 0, At, B0); PG_MMA(0, 1, At, B1); PG_BAR; PG_SCHED;
            PG_LDA(At, 1, 1); PG_STAGE_B(PG_SB(1, 0), b3); PG_STAGE_B(PG_SB(1, 1), b3 + hstepB); PG_STAGE_A(PG_SA(1, 0), a3, q00, q01);
            PG_WAIT_V(8); PG_WAIT_L(0); PG_BAR; PG_MMA(1, 0, At, B0); PG_MMA(1, 1, At, B1); PG_BAR; PG_SCHED;
        }
        if (wr == 0) PG_BAR;
        if constexpr (!Epi::AFTER_DRAIN) { if (cur.flags & UF_LAST) E(acc, cur, wr, wc, fr, fq); else E.mid(acc, cur, wr, wc, fr, fq); }
        if (!has_next) break;
        if (nxt.flags & UF_FIRST) {
#pragma unroll
            for (int a = 0; a < 2; ++a)
#pragma unroll
                for (int b = 0; b < 2; ++b)
#pragma unroll
                    for (int m = 0; m < 4; ++m)
#pragma unroll
                        for (int n = 0; n < 2; ++n) acc[a][b][m][n] = (f32x4){0.f, 0.f, 0.f, 0.f};
        }
        cur = nxt; cA = nA; cB = nB; ++ui;
        if constexpr (GATHER) {
#pragma unroll
            for (int h = 0; h < 2; ++h)
#pragma unroll
                for (int i = 0; i < 2; ++i) oA[h][i] = noA[h][i]; }
        if (wr == 1) PG_BAR;
    }
    PG_WAIT_V(0);
    PG_BAR;
    if constexpr (Epi::AFTER_DRAIN) E.fused(acc, cur, wr, wc, fr, fq, lds, wid, lane);
#undef PG_SA
#undef PG_SB
#undef PG_STAGE_A
#undef PG_STAGE_B
#undef PG_LDA
#undef PG_LDB
#undef PG_MMA
#undef PG_WAIT_V
#undef PG_WAIT_L
#undef PG_BAR
#undef PG_SCHED
#undef PG_GATHER_OFFS
}
}

struct MatDesc { const float* W0; const float* W1; const float* gain; bf16* WT; int K, N, ldw, mode; };
__device__ __forceinline__ void p0_item(const MatDesc& d, float* scr, int item, int lane) {
    const int nblk = d.N / 64, kb = item / nblk, nb = item % nblk, k0 = 32 * kb, n0 = 64 * nb;
    const int c4 = lane & 15, kr = lane >> 4, n = n0 + 4 * c4;
    const float* col;
    if (d.mode == 1) { int src = n; if (n < 2 * DA) { const int seg = n >> 9, pl = (n >> 8) & 1, bj = (n >> 7) & 1, wc = (n >> 5) & 3, w = n & 31; src = seg * DA + (4 * pl + wc) * HD + 32 * bj + w; }
        else if (n >= 4 * DA) { const int np = n - 4 * DA, tile = np >> 8, c = np & 255; src = 4 * DA + (c >> 7) * DM + 128 * tile + (c & 127); }
        col = d.W0 + src; }
    else if (d.mode == 2) { const int hu = (n >> 8) * 128 + (n & 127); col = ((n >> 7) & 1) ? d.W1 + hu : d.W0 + hu; }
    else col = d.W0 + n;
    f32x4 v[8];
#pragma unroll
    for (int i = 0; i < 8; ++i) v[i] = *(const f32x4*)(col + (size_t)(k0 + 4 * i + kr) * d.ldw);
#pragma unroll
    for (int i = 0; i < 8; ++i) { const int kk = 4 * i + kr; const float g = d.gain ? d.gain[k0 + kk] : 1.0f; *(f32x4*)(scr + kk * 68 + 4 * c4) = v[i] * g; }
    asm volatile("s_waitcnt lgkmcnt(0)" ::: "memory");
    const int cq = lane & 3;
#pragma unroll
    for (int j = 0; j < 4; ++j) { const int nn = (lane >> 2) + 16 * j; const float* s = scr + (8 * cq) * 68 + nn;
        v4u o; o.x = pk2(s[0 * 68], s[1 * 68]); o.y = pk2(s[2 * 68], s[3 * 68]); o.z = pk2(s[4 * 68], s[5 * 68]); o.w = pk2(s[6 * 68], s[7 * 68]);
        *(v4u*)(d.WT + (size_t)(n0 + nn) * d.K + k0 + 8 * cq) = o; }
    asm volatile("s_waitcnt lgkmcnt(0)" ::: "memory");
}
constexpr size_t OFF_WIN = 2 * MiB, OFF_WGLU = 10 * MiB, OFF_WA = 11 * MiB, OFF_WS = 12 * MiB, OFF_WOUT = 13 * MiB, OFF_WGU = 15 * MiB, OFF_WD = 31 * MiB, OFF_WSSM = 39 * MiB;
__device__ __forceinline__ void ph_weights(Frame& F, unsigned char* ws, bool first_part, int worker, int nworkers, int wv0 = 0, int nwv = NWAVES) {
    float* scr = (float*)(F.lds + F.wave * 16384);
    const int gw = worker * nwv + (F.wave - wv0), NGW = nworkers * nwv;
    constexpr int I_IN = (DM / 32) * (DIN / 64), I_GLU = (DS / 32) * (DS / 64), I_BR = (DA / 32) * (DM / 64), I_OUT = (DM / 32) * (DM / 64), I_GU = (DM / 32) * (512 / 64), I_D = (DEX / 32) * (DM / 64);
    constexpr int NITEMS = I_IN + I_GLU + 2 * I_BR + I_OUT + NEX * I_GU + NEX * I_D;
    for (int it = (first_part ? 0 : I_IN) + gw; it < (first_part ? I_IN : NITEMS); it += NGW) {
        int r = it; MatDesc d;
        if (r < I_IN) { d = MatDesc{F.w_in, nullptr, F.gain1, (bf16*)(ws + OFF_WIN), DM, DIN, DIN, 1}; }
        else if ((r -= I_IN) < I_GLU) { d = MatDesc{F.w_glu, nullptr, nullptr, (bf16*)(ws + OFF_WGLU), DS, DS, DS, 0}; }
        else if ((r -= I_GLU) < I_BR) { d = MatDesc{F.w_branch, nullptr, nullptr, (bf16*)(ws + OFF_WA), DA, DM, DM, 0}; }
        else if ((r -= I_BR) < I_BR) { d = MatDesc{F.w_branch + (size_t)DA * DM, nullptr, nullptr, (bf16*)(ws + OFF_WS), DS, DM, DM, 0}; }
        else if ((r -= I_BR) < I_OUT) { d = MatDesc{F.w_out, nullptr, nullptr, (bf16*)(ws + OFF_WOUT), DM, DM, DM, 0}; }
        else if ((r -= I_OUT) < NEX * I_GU) { const int e = r / I_GU; r %= I_GU;
            d = MatDesc{F.w_eg + (size_t)e * DM * DEX, F.w_eu + (size_t)e * DM * DEX, F.gain2, (bf16*)(ws + OFF_WGU) + (size_t)e * 512 * DM, DM, 512, DEX, 2}; }
        else { r -= NEX * I_GU; const int e = r / I_D; r %= I_D;
            d = MatDesc{F.w_ed + (size_t)e * DEX * DM, nullptr, nullptr, (bf16*)(ws + OFF_WD) + (size_t)e * DM * DEX, DEX, DM, DM, 0}; }
        p0_item(d, scr, r, F.lane);
    }
}

struct SchedPlain {
    pg::TileOrder o; const char* A; const char* B; int lda_b, ldb_b, nseg, khalf_b; size_t segA, segB;
    __device__ __forceinline__ bool next(int i, pg::Unit& u) const {
        const int ti = (nseg == 2) ? (i >> 1) : i, s = (nseg == 2) ? (i & 1) : 0; int pm, pn;
        if (!o.tile(ti, pm, pn)) return false;
        u.A = A + (size_t)pm * 256 * lda_b + s * segA; u.B = B + (size_t)pn * 256 * ldb_b + s * segB; u.list = nullptr; u.pm = pm; u.pn = pn; u.cnt = 256; u.aux = s;
        u.flags = (s == 0 ? pg::UF_FIRST : 0) | (s == nseg - 1 ? pg::UF_LAST : 0); return true;
    }
};
__device__ __forceinline__ float fast_sigmoid(float x) { return __builtin_amdgcn_rcpf(1.0f + __builtin_amdgcn_exp2f(-LOG2E * x)); }

struct EpiInproj {
    static constexpr bool PERM = true, AFTER_DRAIN = false;
    bf16 *Q, *K, *V, *U, *GT; const float *rstd, *q_gain, *k_gain, *b_gate;
    __device__ __forceinline__ void mid(pg::Acc&, const pg::Unit&, int, int, int, int) const {}
    __device__ __forceinline__ void operator()(pg::Acc& acc, const pg::Unit& u, int wr, int wc, int fr, int fq) const {
        const int row0 = u.pm * 256 + wr * 64 + fr, pn = u.pn;
        float rsv[2][4];
#pragma unroll
        for (int ai = 0; ai < 2; ++ai)
#pragma unroll
            for (int m = 0; m < 4; ++m) rsv[ai][m] = rstd[row0 + ai * 128 + m * 16];
        if (pn < 4) {
            const bool isq = pn < 2; const float* gn = isq ? q_gain : k_gain; const float sc = isq ? QSCALE : 1.0f;
            bf16* base = (isq ? Q : K) + (4 * (pn & 1) + wc) * HD + 8 * fq;
            f32x4 gv[2][2];
#pragma unroll
            for (int bj = 0; bj < 2; ++bj)
#pragma unroll
                for (int n = 0; n < 2; ++n) gv[bj][n] = *(const f32x4*)(gn + 32 * bj + 8 * fq + 4 * n) * sc;
#pragma unroll
            for (int ai = 0; ai < 2; ++ai)
#pragma unroll
                for (int m = 0; m < 4; ++m) { const int row = row0 + ai * 128 + m * 16; const float rs = rsv[ai][m];
                    f32x4 v[2][2]; float ss = 0.f;
#pragma unroll
                    for (int bj = 0; bj < 2; ++bj)
#pragma unroll
                        for (int n = 0; n < 2; ++n) { v[bj][n] = acc[ai][bj][m][n] * rs; const f32x4 q = v[bj][n] * v[bj][n]; ss += (q[0] + q[1]) + (q[2] + q[3]); }
                    ss += __shfl_xor(ss, 16); ss += __shfl_xor(ss, 32);
                    const float r = 1.0f / sqrtf(ss * (1.0f / HD) + EPS);
#pragma unroll
                    for (int bj = 0; bj < 2; ++bj) { const f32x4 a = v[bj][0] * gv[bj][0] * r, b = v[bj][1] * gv[bj][1] * r;
                        pg::u32x4 w; w.x = pg::cvt_pk_bf16(a[0], a[1]); w.y = pg::cvt_pk_bf16(a[2], a[3]); w.z = pg::cvt_pk_bf16(b[0], b[1]); w.w = pg::cvt_pk_bf16(b[2], b[3]);
                        *(pg::u32x4*)(base + (size_t)row * DA + 32 * bj) = w; } }
        } else if (pn < 8) {
            const bool isv = pn < 6;
#pragma unroll
            for (int ai = 0; ai < 2; ++ai)
#pragma unroll
                for (int m = 0; m < 4; ++m) { const int row = row0 + ai * 128 + m * 16; const float rs = rsv[ai][m];
#pragma unroll
                    for (int bj = 0; bj < 2; ++bj) { const f32x4 a = acc[ai][bj][m][0] * rs, b = acc[ai][bj][m][1] * rs;
                        pg::u32x4 w; w.x = pg::cvt_pk_bf16(a[0], a[1]); w.y = pg::cvt_pk_bf16(a[2], a[3]); w.z = pg::cvt_pk_bf16(b[0], b[1]); w.w = pg::cvt_pk_bf16(b[2], b[3]);
                        const int col = (pn & 1) * 256 + bj * 128 + wc * 32 + 8 * fq;
                        bf16* dst = isv ? V + (size_t)row * DA + col : U + ((size_t)(col >> 4) * T + row) * SGC + (col & 15);
                        *(pg::u32x4*)dst = w; } }
        } else {
            const int nm0 = (pn - 8) * 128 + 32 * wc + 8 * fq;
            f32x4 bv[2][2];
#pragma unroll
            for (int bj = 0; bj < 2; ++bj)
#pragma unroll
                for (int n = 0; n < 2; ++n) bv[bj][n] = *(const f32x4*)(b_gate + bj * DM + nm0 + 4 * n);
            unsigned char* G8 = (unsigned char*)GT;
#pragma unroll
            for (int ai = 0; ai < 2; ++ai)
#pragma unroll
                for (int m = 0; m < 4; ++m) { const int row = row0 + ai * 128 + m * 16; const float rs = rsv[ai][m]; pg::u32x4 w;
#pragma unroll
                    for (int bj = 0; bj < 2; ++bj)
#pragma unroll
                        for (int n = 0; n < 2; ++n) { const f32x4 a = acc[ai][bj][m][n] * rs + bv[bj][n]; unsigned pk = 0u;
#pragma unroll
                            for (int i = 0; i < 4; ++i) { const float g = fast_sigmoid(a[i]); const unsigned q = (unsigned)__builtin_fminf(__builtin_fmaxf(g * 255.0f + 0.5f, 1.0f), 255.0f); pk |= q << (8 * i); }
                            w[2 * bj + n] = pk; }
                    *(pg::u32x4*)(G8 + (size_t)row * (2 * DM) + (size_t)(nm0 >> 3) * 16) = w; }
        }
    }
};
__device__ __forceinline__ void unpack8(const pg::u32x4 w, f32x4& a, f32x4& b) { a = (f32x4){bflo(w.x), bfhi(w.x), bflo(w.y), bfhi(w.y)}; b = (f32x4){bflo(w.z), bfhi(w.z), bflo(w.w), bfhi(w.w)}; }
struct EpiGlu {
    static constexpr bool PERM = true, AFTER_DRAIN = false;
    const bf16* Z; bf16* YS; const float* b_glu;
    __device__ __forceinline__ void mid(pg::Acc&, const pg::Unit&, int, int, int, int) const {}
    __device__ __forceinline__ void operator()(pg::Acc& acc, const pg::Unit& u, int wr, int wc, int fr, int fq) const {
        const int row0 = u.pm * 256 + wr * 64 + fr, col0 = u.pn * 256 + wc * 32 + 8 * fq;
        f32x4 bv[2][2];
#pragma unroll
        for (int bj = 0; bj < 2; ++bj)
#pragma unroll
            for (int n = 0; n < 2; ++n) bv[bj][n] = *(const f32x4*)(b_glu + col0 + bj * 128 + 4 * n);
#pragma unroll
        for (int ai = 0; ai < 2; ++ai)
#pragma unroll
            for (int m = 0; m < 4; ++m) { const size_t ro = (size_t)(row0 + ai * 128 + m * 16) * DS + col0;
#pragma unroll
                for (int bj = 0; bj < 2; ++bj) { f32x4 z0, z1; unpack8(*(const pg::u32x4*)(Z + ro + bj * 128), z0, z1);
                    const f32x4 a = acc[ai][bj][m][0] + bv[bj][0], b = acc[ai][bj][m][1] + bv[bj][1];
                    pg::u32x4 w; w.x = pg::cvt_pk_bf16(z0[0] * fast_sigmoid(a[0]), z0[1] * fast_sigmoid(a[1])); w.y = pg::cvt_pk_bf16(z0[2] * fast_sigmoid(a[2]), z0[3] * fast_sigmoid(a[3]));
                    w.z = pg::cvt_pk_bf16(z1[0] * fast_sigmoid(b[0]), z1[1] * fast_sigmoid(b[1])); w.w = pg::cvt_pk_bf16(z1[2] * fast_sigmoid(b[2]), z1[3] * fast_sigmoid(b[3]));
                    *(pg::u32x4*)(YS + ro + bj * 128) = w; } }
    }
};
__device__ __forceinline__ void unpack_u8x4(unsigned w, f32x4& o) { o = (f32x4){(float)(w & 255u), (float)((w >> 8) & 255u), (float)((w >> 16) & 255u), (float)(w >> 24)}; }
struct EpiBranch {
    static constexpr bool PERM = true, AFTER_DRAIN = false;
    const unsigned char* G8; bf16* MG;
    __device__ __forceinline__ void mid(pg::Acc& acc, const pg::Unit& u, int wr, int wc, int fr, int fq) const {
        const int row0 = u.pm * 256 + wr * 64 + fr, blk0 = u.pn * 32 + wc * 4 + fq;
#pragma unroll
        for (int ai = 0; ai < 2; ++ai) { pg::u32x4 g[4][2];
#pragma unroll
            for (int m = 0; m < 4; ++m)
#pragma unroll
                for (int bj = 0; bj < 2; ++bj) g[m][bj] = *(const pg::u32x4*)(G8 + (size_t)(row0 + ai * 128 + m * 16) * (2 * DM) + (size_t)(blk0 + 16 * bj) * 16);
#pragma unroll
            for (int m = 0; m < 4; ++m)
#pragma unroll
                for (int bj = 0; bj < 2; ++bj) { f32x4 a0, a1, b0, b1; unpack_u8x4(g[m][bj].x, a0); unpack_u8x4(g[m][bj].y, a1); unpack_u8x4(g[m][bj].z, b0); unpack_u8x4(g[m][bj].w, b1);
#pragma unroll
                    for (int i = 0; i < 4; ++i) { acc[ai][bj][m][0][i] *= a0[i] * __builtin_amdgcn_rcpf(b0[i]); acc[ai][bj][m][1][i] *= a1[i] * __builtin_amdgcn_rcpf(b1[i]); } } }
    }
    __device__ __forceinline__ void operator()(pg::Acc& acc, const pg::Unit& u, int wr, int wc, int fr, int fq) const {
        const int row0 = u.pm * 256 + wr * 64 + fr, col0 = u.pn * 256 + wc * 32 + 8 * fq, blk0 = u.pn * 32 + wc * 4 + fq;
#pragma unroll
        for (int ai = 0; ai < 2; ++ai) { pg::u32x2 g[4][2];
#pragma unroll
            for (int m = 0; m < 4; ++m)
#pragma unroll
                for (int bj = 0; bj < 2; ++bj) g[m][bj] = *(const pg::u32x2*)(G8 + (size_t)(row0 + ai * 128 + m * 16) * (2 * DM) + (size_t)(blk0 + 16 * bj) * 16 + 8);
#pragma unroll
            for (int m = 0; m < 4; ++m)
#pragma unroll
                for (int bj = 0; bj < 2; ++bj) { f32x4 g0, g1; unpack_u8x4(g[m][bj].x, g0); unpack_u8x4(g[m][bj].y, g1); const f32x4 a = acc[ai][bj][m][0] * g0 * (1.0f / 255.0f), b = acc[ai][bj][m][1] * g1 * (1.0f / 255.0f);
                    pg::u32x4 w; w.x = pg::cvt_pk_bf16(a[0], a[1]); w.y = pg::cvt_pk_bf16(a[2], a[3]); w.z = pg::cvt_pk_bf16(b[0], b[1]); w.w = pg::cvt_pk_bf16(b[2], b[3]);
                    *(pg::u32x4*)(MG + (size_t)(row0 + ai * 128 + m * 16) * DM + col0 + bj * 128) = w; } }
    }
};
struct EpiOut {
    static constexpr bool PERM = true, AFTER_DRAIN = false;
    bf16* XB;
    __device__ __forceinline__ void mid(pg::Acc&, const pg::Unit&, int, int, int, int) const {}
    __device__ __forceinline__ void operator()(pg::Acc& acc, const pg::Unit& u, int wr, int wc, int fr, int fq) const {
        const int row0 = u.pm * 256 + wr * 64 + fr, col0 = u.pn * 256 + wc * 32 + 8 * fq;
        pg::u32x4 xv[2][4][2];
#pragma unroll
        for (int ai = 0; ai < 2; ++ai)
#pragma unroll
            for (int m = 0; m < 4; ++m)
#pragma unroll
                for (int bj = 0; bj < 2; ++bj) xv[ai][m][bj] = *(const pg::u32x4*)(XB + (size_t)(row0 + ai * 128 + m * 16) * DM + col0 + bj * 128);
#pragma unroll
        for (int ai = 0; ai < 2; ++ai)
#pragma unroll
            for (int m = 0; m < 4; ++m)
#pragma unroll
                for (int bj = 0; bj < 2; ++bj) { f32x4 x0, x1; unpack8(xv[ai][m][bj], x0, x1); const f32x4 a = x0 + acc[ai][bj][m][0], b = x1 + acc[ai][bj][m][1];
                    pg::u32x4 w; w.x = pg::cvt_pk_bf16(a[0], a[1]); w.y = pg::cvt_pk_bf16(a[2], a[3]); w.z = pg::cvt_pk_bf16(b[0], b[1]); w.w = pg::cvt_pk_bf16(b[2], b[3]);
                    *(pg::u32x4*)(XB + (size_t)(row0 + ai * 128 + m * 16) * DM + col0 + bj * 128) = w; }
    }
};
constexpr int MOE_TAB_OFF = LDSCTL_OFF + 1024;
__device__ __forceinline__ void moe_build_tab(Frame& F) {
    LAS int* tab = (LAS int*)((LAS unsigned char*)F.lds + MOE_TAB_OFF);
    if (F.tid < NCLS) tab[32 + F.tid] = (int)__hip_atomic_load(F.ctl + CW_CNT + 64 * F.tid, __ATOMIC_RELAXED, __HIP_MEMORY_SCOPE_AGENT);
    __syncthreads();
    if (F.tid == 0) { int acc = 0;
        for (int c = 0; c < NCLS; ++c) { tab[c] = acc; acc += (tab[32 + c] + 255) >> 8; }
        tab[NCLS] = acc; }
    __syncthreads();
}
struct SchedMoe {
    const LAS int* tab; int G, c, nseg, mode; const char* A; const char* B; const int* LIST;
    __device__ __forceinline__ bool next(int i, pg::Unit& u) const {
        const int ti = (nseg == 2) ? (i >> 1) : i, s = (nseg == 2) ? (i & 1) : 0;
        const int L = ti * G + c; if (L >= tab[NCLS] * 4) return false;
        const int tileIdx = L >> 2, pn = L & 3; int cls = 0;
        while (tab[cls + 1] <= tileIdx) ++cls;
        const int tile = tileIdx - tab[cls]; int cnt = tab[32 + cls] - tile * 256; cnt = cnt > 256 ? 256 : cnt;
        const int grp = cls / 6; int lo, hi; pair_decode(cls % 6, lo, hi);
        u.list = LIST + (size_t)cls * T + tile * 256; u.cnt = cnt; u.pm = cls; u.pn = pn;
        if (mode == 0) { const int e = grp * 4 + ((pn >> 1) ? hi : lo); u.A = A; u.B = B + ((size_t)e * 512 + (pn & 1) * 256) * (DM * 2); u.aux = pn >> 1; }
        else { u.A = A; u.B = B + ((size_t)(grp * 4 + lo) * DM + pn * 256) * (DEX * 2); u.aux = (hi - lo) * DM * DEX * 2; }
        u.flags = (s == 0 ? pg::UF_FIRST : 0) | (s == nseg - 1 ? pg::UF_LAST : 0); return true;
    }
};
struct EpiGateUp {
    static constexpr bool PERM = true, AFTER_DRAIN = false;
    bf16* HID; const float* rstd2; const float* tokw;
    __device__ __forceinline__ void mid(pg::Acc&, const pg::Unit&, int, int, int, int) const {}
    __device__ __forceinline__ void operator()(pg::Acc& acc, const pg::Unit& u, int wr, int wc, int fr, int fq) const {
        const int slot = u.aux, hcol = slot * DEX + (u.pn & 1) * 128 + 32 * wc + 8 * fq;
#pragma unroll
        for (int ai = 0; ai < 2; ++ai) { int tok[4]; float rs[4], ww[4];
#pragma unroll
            for (int m = 0; m < 4; ++m) { const int r = ai * 128 + wr * 64 + m * 16 + fr; tok[m] = u.list[r < u.cnt ? r : 0]; }
#pragma unroll
            for (int m = 0; m < 4; ++m) { rs[m] = rstd2[tok[m]]; ww[m] = tokw[2 * tok[m] + slot]; }
#pragma unroll
            for (int m = 0; m < 4; ++m) { const int r = ai * 128 + wr * 64 + m * 16 + fr;
                if (r < u.cnt) { pg::u32x4 o;
#pragma unroll
                    for (int n = 0; n < 2; ++n) { const f32x4 g = acc[ai][0][m][n] * rs[m], up = acc[ai][1][m][n] * rs[m]; f32x4 h;
#pragma unroll
                        for (int i = 0; i < 4; ++i) h[i] = g[i] * fast_sigmoid(g[i]) * up[i] * ww[m];
                        o[2 * n] = pg::cvt_pk_bf16(h[0], h[1]); o[2 * n + 1] = pg::cvt_pk_bf16(h[2], h[3]); }
                    *(pg::u32x4*)(HID + (size_t)tok[m] * 512 + hcol) = o; } } }
    }
};
struct EpiDown {
    static constexpr bool PERM = false, AFTER_DRAIN = false;
    float* out; const bf16* XB;
    __device__ __forceinline__ void mid(pg::Acc&, const pg::Unit&, int, int, int, int) const {}
    __device__ __forceinline__ void operator()(pg::Acc& acc, const pg::Unit& u, int wr, int wc, int fr, int fq) const {
        const int col0 = u.pn * 256 + wc * 32 + 4 * fq;
        int tok[2][4];
#pragma unroll
        for (int ai = 0; ai < 2; ++ai)
#pragma unroll
            for (int m = 0; m < 4; ++m) { const int r = ai * 128 + wr * 64 + m * 16 + fr; tok[ai][m] = u.list[r < u.cnt ? r : 0]; }
#pragma unroll
        for (int ai = 0; ai < 2; ++ai)
#pragma unroll
            for (int mp = 0; mp < 2; ++mp) { pg::u32x2 xb[2][2][2];
#pragma unroll
                for (int mm = 0; mm < 2; ++mm)
#pragma unroll
                    for (int bj = 0; bj < 2; ++bj)
#pragma unroll
                        for (int n = 0; n < 2; ++n) xb[mm][bj][n] = *(const pg::u32x2*)(XB + (size_t)tok[ai][2 * mp + mm] * DM + col0 + bj * 128 + n * 16);
#pragma unroll
                for (int mm = 0; mm < 2; ++mm) { const int m = 2 * mp + mm, r = ai * 128 + wr * 64 + m * 16 + fr;
                    if (r < u.cnt) {
#pragma unroll
                        for (int bj = 0; bj < 2; ++bj)
#pragma unroll
                            for (int n = 0; n < 2; ++n) { const pg::u32x2 w = xb[mm][bj][n];
                                *(f32x4*)(out + (size_t)tok[ai][m] * DM + col0 + bj * 128 + n * 16) = (f32x4){bflo(w.x), bfhi(w.x), bflo(w.y), bfhi(w.y)} + acc[ai][bj][m][n]; } } } }
    }
};
namespace att {
typedef short bf16x8 __attribute__((ext_vector_type(8)));
typedef short s16x4 __attribute__((ext_vector_type(4)));
typedef float f32x16 __attribute__((ext_vector_type(16)));
typedef short v4i16_t __attribute__((ext_vector_type(4)));
constexpr int SLOT = 32768, RING = 3 * SLOT, NBT = 384, BIAS_OFF = RING, WS_OFF = BIAS_OFF + 2 * NBT * 4, OST_OFF = 0;
__device__ __forceinline__ int crow(int r, int hi) { return (r & 3) + 8 * (r >> 2) + 4 * hi; }
__device__ __forceinline__ s16x4 vtr(const LAS unsigned char* p) { return __builtin_bit_cast(s16x4, __builtin_amdgcn_ds_read_tr16_b64_v4i16((LAS v4i16_t*)p)); }
__device__ __forceinline__ float max3f(float a, float b, float c) { return __builtin_fmaxf(__builtin_fmaxf(a, b), c); }
#define ATT_WAIT_BAR(N) asm volatile("s_waitcnt vmcnt(" #N ") lgkmcnt(0)\n\ts_barrier" ::: "memory")

struct AttState { float m, l; f32x16 o[2]; };
template <int SLC>
__device__ __forceinline__ void att_step(LAS unsigned char* L, int j, int ci, int hh, int qi, int r32, int hi, int lane, const bf16x8 (&qr)[4], const LAS float* biasL, LAS float* wsf, AttState& S) {
    if (j >= ci && j <= ci + LEFT) {
        const int dc = ci + LEFT - j;
        const LAS unsigned char* Kb = L + SLC * SLOT + hh * 16384; const LAS unsigned char* Vb = Kb + 8192;
        f32x16 p0, p1;
        if (dc >= 5) { const float bc = biasL[NREL - 1] - S.m;
#pragma unroll
            for (int r = 0; r < 16; ++r) { p0[r] = bc; p1[r] = bc; } }
        else { const LAS float* bp = biasL + (64 * dc + qi + 4 - 4 * hi);
#pragma unroll
            for (int r = 0; r < 16; ++r) { const int k = (r & 3) + 8 * (r >> 2); p0[r] = bp[59 - k] - S.m; p1[r] = bp[27 - k] - S.m; } }
        { const LAS unsigned char* kb = Kb + r32 * 128;
#pragma unroll
          for (int d0 = 0; d0 < 4; ++d0) { const int sl = ((2 * d0 + hi) ^ (r32 & 7)) << 4; const bf16x8 b0 = *(const LAS bf16x8*)(kb + sl), b1 = *(const LAS bf16x8*)(kb + 4096 + sl);
              p0 = __builtin_amdgcn_mfma_f32_32x32x16_bf16(b0, qr[d0], p0, 0, 0, 0); p1 = __builtin_amdgcn_mfma_f32_32x32x16_bf16(b1, qr[d0], p1, 0, 0, 0); } }
        float rm;
        { float a = max3f(p0[0], p0[1], p1[0]), bb = max3f(p0[2], p0[3], p1[1]); a = max3f(a, p1[2], p1[3]);
#pragma unroll
          for (int r = 4; r < 16; r += 4) { a = max3f(a, p0[r], p0[r + 1]); bb = max3f(bb, p0[r + 2], p0[r + 3]); a = max3f(a, p1[r], p1[r + 1]); bb = max3f(bb, p1[r + 2], p1[r + 3]); }
          rm = __builtin_fmaxf(a, bb); rm = __builtin_fmaxf(rm, __shfl_xor(rm, 32)); }
        if (__any(rm > 8.0f)) {
            const float dl = __builtin_fmaxf(rm, 0.f), alpha = __builtin_amdgcn_exp2f(-dl); S.m += dl; S.l *= alpha;
            if (hi == 0) wsf[r32] = alpha;
#pragma unroll
            for (int r = 0; r < 16; ++r) { p0[r] -= dl; p1[r] -= dl; }
            asm volatile("s_waitcnt lgkmcnt(0)" ::: "memory");
#pragma unroll
            for (int r = 0; r < 16; ++r) { const float f = wsf[crow(r, hi)]; S.o[0][r] *= f; S.o[1][r] *= f; }
        }
        float sacc = 0.f;
#pragma unroll
        for (int r = 0; r < 16; ++r) { p0[r] = __builtin_amdgcn_exp2f(p0[r]); p1[r] = __builtin_amdgcn_exp2f(p1[r]); sacc += p0[r] + p1[r]; }
        S.l += sacc;
        pg::u32x4 pw[4];
#pragma unroll
        for (int k = 0; k < 2; ++k) { pw[k] = (pg::u32x4){pg::cvt_pk_bf16(p0[8 * k], p0[8 * k + 1]), pg::cvt_pk_bf16(p0[8 * k + 2], p0[8 * k + 3]), pg::cvt_pk_bf16(p0[8 * k + 4], p0[8 * k + 5]), pg::cvt_pk_bf16(p0[8 * k + 6], p0[8 * k + 7])};
            pw[2 + k] = (pg::u32x4){pg::cvt_pk_bf16(p1[8 * k], p1[8 * k + 1]), pg::cvt_pk_bf16(p1[8 * k + 2], p1[8 * k + 3]), pg::cvt_pk_bf16(p1[8 * k + 4], p1[8 * k + 5]), pg::cvt_pk_bf16(p1[8 * k + 6], p1[8 * k + 7])}; }
        const int vb = (int)(unsigned)(__UINTPTR_TYPE__)(Vb + ((lane >> 4) & 1) * 32 + (lane & 3) * 8 + (4 * hi + ((lane & 15) >> 2)) * 64);
#pragma unroll
        for (int d0 = 0; d0 < 2; ++d0) { s16x4 lo[4], hq[4];
#pragma unroll
            for (int ks = 0; ks < 4; ++ks) {
                asm volatile("ds_read_b64_tr_b16 %0, %1 offset:%c2" : "=&v"(lo[ks]) : "v"(vb), "i"(d0 * 4096 + ks * 1024) : "memory");
                asm volatile("ds_read_b64_tr_b16 %0, %1 offset:%c2" : "=&v"(hq[ks]) : "v"(vb), "i"(d0 * 4096 + ks * 1024 + 512) : "memory"); }
            asm volatile("s_waitcnt lgkmcnt(0)" ::: "memory"); __builtin_amdgcn_sched_barrier(0);
#pragma unroll
            for (int ks = 0; ks < 4; ++ks) { const bf16x8 vf = (bf16x8){lo[ks][0], lo[ks][1], lo[ks][2], lo[ks][3], hq[ks][0], hq[ks][1], hq[ks][2], hq[ks][3]};
                S.o[d0] = __builtin_amdgcn_mfma_f32_32x32x16_bf16(__builtin_bit_cast(bf16x8, pw[ks]), vf, S.o[d0], 0, 0, 0); } }
    }
}
__device__ __forceinline__ void attn_unit(Frame& F, int b, int hp, int cp) {
    LAS unsigned char* L = (LAS unsigned char*)F.lds;
    const int tid = F.tid, lane = F.lane, r32 = lane & 31, hi = lane >> 5, wid = F.wave;
    const int hh = wid >> 2, h = 2 * hp + hh, qb = wid & 3, ci = qb >> 1, qh = qb & 1, c0 = 2 * cp;
    const int trow = b * SEQ + (c0 + ci) * CHK + qh * 32;
    const LAS float* biasL = (const LAS float*)(L + BIAS_OFF) + hh * NBT;
    LAS float* wsf = (LAS float*)(L + WS_OFF) + wid * 64;
    for (int idx = tid; idx < 2 * NBT; idx += NTHR) { const int hd = idx / NBT, e = idx % NBT; ((LAS float*)(L + BIAS_OFF))[idx] = F.rel_bias[(2 * hp + hd) * NREL + (e < NREL ? e : NREL - 1)] * LOG2E; }
    bf16x8 qr[4];
#pragma unroll
    for (int d0 = 0; d0 < 4; ++d0) qr[d0] = *(const bf16x8*)(F.Q + (size_t)(trow + r32) * DA + h * HD + d0 * 16 + hi * 8);
    const int j0 = c0 >= LEFT ? 0 : LEFT - c0;
    const long krow0 = (long)b * SEQ + (long)(c0 - LEFT) * CHK;
    const bf16* ksrc = F.K + (2 * hp) * HD + (((lane & 7) ^ (lane >> 3)) << 3) + (long)(8 * wid + (lane >> 3)) * DA;
    const bf16* vsrc = F.V + (2 * hp) * HD + (wid >> 2) * 32 + (lane & 3) * 8 + (long)(16 * (wid & 3) + (lane >> 2)) * DA;
    const unsigned pieceoff = (unsigned)wid * 1024u;
#define ATT_ISSUE(jt, SL) do { const long ro_ = (krow0 + (long)(jt) * CHK) * DA; \
        __builtin_amdgcn_global_load_lds((const unsigned*)(ksrc + ro_), (LAS unsigned*)(L + (SL) * SLOT + pieceoff), 16, 0, 0); \
        __builtin_amdgcn_global_load_lds((const unsigned*)(vsrc + ro_), (LAS unsigned*)(L + (SL) * SLOT + 8192 + pieceoff), 16, 0, 0); \
        __builtin_amdgcn_global_load_lds((const unsigned*)(ksrc + ro_ + HD), (LAS unsigned*)(L + (SL) * SLOT + 16384 + pieceoff), 16, 0, 0); \
        __builtin_amdgcn_global_load_lds((const unsigned*)(vsrc + ro_ + HD), (LAS unsigned*)(L + (SL) * SLOT + 24576 + pieceoff), 16, 0, 0); } while (0)
    ATT_ISSUE(j0, 0);
    if (j0 + 1 < 10) ATT_ISSUE(j0 + 1, 1);
    AttState S; S.m = -1000.f; S.l = 0.f;
#pragma unroll
    for (int r = 0; r < 16; ++r) { S.o[0][r] = 0.f; S.o[1][r] = 0.f; }
    const int qi = qh * 32 + r32;
    if (j0 + 1 < 10) ATT_WAIT_BAR(4); else ATT_WAIT_BAR(0);
#define ATT_STEPX(SLC) { if (j + 2 < 10) ATT_ISSUE(j + 2, ((SLC) + 2) % 3); att_step<SLC>(L, j, ci, hh, qi, r32, hi, lane, qr, biasL, wsf, S); if (j + 2 < 10) ATT_WAIT_BAR(4); else ATT_WAIT_BAR(0); if (++j >= 10) break; }
    { int j = j0;
#pragma unroll 1
      for (;;) { ATT_STEPX(0) ATT_STEPX(1) ATT_STEPX(2) } }
#undef ATT_STEPX
#undef ATT_ISSUE
    float l = S.l; l += __shfl_xor(l, 32);
    if (hi == 0) wsf[32 + r32] = 1.0f / l;
    asm volatile("s_waitcnt lgkmcnt(0)" ::: "memory");
    LAS bf16* stg = (LAS bf16*)(L + OST_OFF) + wid * 2048;
#pragma unroll
    for (int r = 0; r < 16; ++r) { const int orow = crow(r, hi); const float f = wsf[32 + orow];
        stg[orow * 64 + r32] = (bf16)f2bf(S.o[0][r] * f); stg[orow * 64 + 32 + r32] = (bf16)f2bf(S.o[1][r] * f); }
    asm volatile("s_waitcnt lgkmcnt(0)" ::: "memory");
    bf16* Ow = F.YA + (size_t)trow * DA + h * HD;
#pragma unroll
    for (int i = 0; i < 4; ++i) { const int row = i * 8 + (lane >> 3), ch = lane & 7; const v4u v = *(const LAS v4u*)(stg + row * 64 + ch * 8); *(v4u*)(Ow + (size_t)row * DA + ch * 8) = v; }
    ATT_WAIT_BAR(0);
}
__device__ __forceinline__ void attn_phase(Frame& F) {
    volatile LAS int* qslot = (volatile LAS int*)((LAS unsigned char*)F.lds + LDSCTL_OFF + 2048);
#pragma unroll 1
    for (;;) {
        if (F.tid == 0) *qslot = (int)xb_add(F.ctl + CW_ATTQ, 1u);
        __syncthreads();
        const int q = *qslot;
        __syncthreads();
        if (q >= NB * 4 * 16) break;
        int pr, cp;
        if (q < 64 * 12) { pr = q / 12; cp = 4 + q % 12; } else { const int r = q - 64 * 12; cp = 3 - (r >> 6); pr = r & 63; }
        attn_unit(F, pr >> 2, pr & 3, cp);
    }
}
#undef ATT_WAIT_BAR
}

constexpr size_t OFF_SLOC = 384 * MiB, OFF_SIN = 400 * MiB;
constexpr size_t TAB_A = 0, TAB_A32 = 16 * 1024, TAB_A64 = 32 * 1024, TAB_BB = 64 * 1024, TAB_CM = 256 * 1024;
typedef float f32x2v __attribute__((ext_vector_type(2)));
struct SsmCoef { float lre, lim, step, a_re, a_im, f_re, f_im; };
__device__ __forceinline__ SsmCoef ssm_coef(const Frame& F, int g, int p) {
    SsmCoef c; c.lre = F.lam_re[g * NST + p]; c.lim = F.lam_im[g * NST + p]; c.step = expf(F.log_step[g]);
    const float mag = expf(c.lre * c.step), ang = c.lim * c.step; c.a_re = mag * cosf(ang); c.a_im = mag * sinf(ang);
    const float nr = c.a_re - 1.0f, ni = c.a_im, den = c.lre * c.lre + c.lim * c.lim;
    c.f_re = (nr * c.lre + ni * c.lim) / den; c.f_im = (ni * c.lre - nr * c.lim) / den; return c;
}
__device__ __forceinline__ f32x2v ssm_apow(const SsmCoef& c, int n) { const float mag = expf((float)n * c.lre * c.step), ang = (float)n * (c.lim * c.step); return (f32x2v){mag * cosf(ang), mag * sinf(ang)}; }
__device__ __forceinline__ void ph_ssmtab(Frame& F, unsigned char* ws, int thr0) {
    unsigned char* tab = ws + OFF_TAB;
    const int gt = F.vcu * (NTHR - thr0) + (F.tid - thr0), NT_ = F.G * (NTHR - thr0);
    for (int idx = gt; idx < NGR * NST; idx += NT_) { const int g = idx / NST, p = idx % NST; const SsmCoef c = ssm_coef(F, g, p);
        ((f32x2v*)(tab + TAB_A))[idx] = (f32x2v){c.a_re, c.a_im}; ((f32x2v*)(tab + TAB_A32))[idx] = ssm_apow(c, 32); ((f32x2v*)(tab + TAB_A64))[idx] = ssm_apow(c, 64); }
    for (int idx = gt; idx < NGR * 4 * 64; idx += NT_) { const int lane = idx & 63, st = (idx >> 6) & 3, g = idx >> 8, p = 32 * (st >> 1) + (lane & 31), part = st & 1;
        const SsmCoef c = ssm_coef(F, g, p); unsigned w[4];
#pragma unroll
        for (int j = 0; j < 8; j += 2) { float v[2];
#pragma unroll
            for (int q = 0; q < 2; ++q) { const int ch = 8 * (lane >> 5) + j + q; const float br = F.sb_re[(g * NST + p) * SGC + ch], bi = F.sb_im[(g * NST + p) * SGC + ch]; v[q] = part ? (c.f_re * bi + c.f_im * br) : (c.f_re * br - c.f_im * bi); }
            w[j >> 1] = pk2(v[0], v[1]); }
        ((v4u*)(tab + TAB_BB))[idx] = (v4u){w[0], w[1], w[2], w[3]}; }
    for (int idx = gt; idx < NGR * 5 * 64; idx += NT_) { const int lane = idx & 63, ks = (idx >> 6) % 5, g = idx / 320, col = lane & 15; unsigned w[4];
#pragma unroll
        for (int j = 0; j < 8; j += 2) { float v[2];
#pragma unroll
            for (int q = 0; q < 2; ++q) { const int k = 8 * (lane >> 4) + j + q + 32 * ks;
                if (ks < 4) { const int p = k >> 1; v[q] = (k & 1) ? -F.sc_im[(g * SGC + col) * NST + p] : F.sc_re[(g * SGC + col) * NST + p]; }
                else { const int kk = k - 128; v[q] = (kk == col) ? F.ssm_d[g * SGC + col] : 0.f; } }
            w[j >> 1] = pk2(v[0], v[1]); }
        ((v4u*)(tab + TAB_CM))[idx] = (v4u){w[0], w[1], w[2], w[3]}; }
    bf16* W = (bf16*)(ws + OFF_WSSM);
    for (int idx = gt; idx < NGR * 256 * 8; idx += NT_) { const int jb = idx & 7, n = (idx >> 3) & 255, g = idx >> 11, p = (n & 127) >> 1, part = n & 1, e0 = ((n >> 7) ? 24 : 56) - 8 * jb;
        v4u* dst = (v4u*)(W + ((size_t)(g * 256 + n)) * 1024 + jb * 128);
        if (e0 < 0) {
#pragma unroll
            for (int q = 0; q < 16; ++q) dst[q] = (v4u){0u, 0u, 0u, 0u}; }
        else { const SsmCoef c = ssm_coef(F, g, p); const f32x2v pw = ssm_apow(c, e0); float gr = pw.x * c.f_re - pw.y * c.f_im, gi = pw.x * c.f_im + pw.y * c.f_re;
            float br[SGC], bi[SGC];
#pragma unroll
            for (int ch = 0; ch < SGC; ++ch) { br[ch] = F.sb_re[(g * NST + p) * SGC + ch]; bi[ch] = F.sb_im[(g * NST + p) * SGC + ch]; }
#pragma unroll
            for (int sI = 0; sI < 8; ++sI) { const int j = 7 - sI; unsigned w[8];
#pragma unroll
                for (int q = 0; q < 8; ++q) { const float v0 = part ? (gr * bi[2 * q] + gi * br[2 * q]) : (gr * br[2 * q] - gi * bi[2 * q]), v1 = part ? (gr * bi[2 * q + 1] + gi * br[2 * q + 1]) : (gr * br[2 * q + 1] - gi * bi[2 * q + 1]); w[q] = pk2(v0, v1); }
                dst[2 * j] = (v4u){w[0], w[1], w[2], w[3]}; dst[2 * j + 1] = (v4u){w[4], w[5], w[6], w[7]};
                const float ngr = gr * c.a_re - gi * c.a_im, ngi = gr * c.a_im + gi * c.a_re; gr = ngr; gi = ngi; } }
    }
}
struct SchedSloc {
    const char* U; const char* W; int c;
    __device__ __forceinline__ bool next(int i, pg::Unit& u) const {
        if (i != 0 || c >= NGR * 2) return false;
        const int g = c >> 1, mt = c & 1;
        u.A = U + ((size_t)g * T * SGC + (size_t)mt * 256 * 1024) * 2; u.B = W + (size_t)g * 256 * 1024 * 2; u.list = nullptr; u.pm = mt; u.pn = 0; u.cnt = 256; u.aux = g; u.flags = pg::UF_FIRST | pg::UF_LAST; return true;
    }
};
struct EpiSloc {
    static constexpr bool PERM = false, AFTER_DRAIN = true;
    float* SIN; const f32x2v* A32; const f32x2v* A64;
    __device__ __forceinline__ void mid(pg::Acc&, const pg::Unit&, int, int, int, int) const {}
    __device__ __forceinline__ void operator()(pg::Acc&, const pg::Unit&, int, int, int, int) const {}
    __device__ __forceinline__ void fused(pg::Acc& acc, const pg::Unit& u, int wr, int wc, int fr, int fq, LAS unsigned char* lds, int wid, int lane) const {
        LAS float* Lf = (LAS float*)lds;
        const int g = u.aux, tid = wid * 64 + lane, bl = tid >> 6, p = tid & 63, b = u.pm * 8 + bl;
        f32x2v sin[NCH];
#pragma unroll
        for (int half = 0; half < 2; ++half) {
#pragma unroll
            for (int ai = 0; ai < 2; ++ai)
#pragma unroll
                for (int m = 0; m < 4; ++m)
#pragma unroll
                    for (int n = 0; n < 2; ++n) { const int row = ai * 128 + wr * 64 + m * 16 + fr; *(LAS f32x4*)(Lf + row * 128 + (((8 * wc + 4 * n + fq) ^ (row & 31)) << 2)) = acc[ai][half][m][n]; }
            __syncthreads();
            float* sp = SIN + ((((size_t)b * NCH) * NGR + g) * 2 + half) * 128 + 2 * p;
            if (half == 0) { const f32x2v a = A64[g * NST + p]; f32x2v s = (f32x2v){0.f, 0.f};
#pragma unroll
                for (int c = 0; c < NCH; ++c) { sin[c] = s; *(f32x2v*)(sp + (size_t)c * NGR * 256) = s;
                    const f32x2v loc = *(const LAS f32x2v*)(Lf + (bl * 32 + c) * 128 + ((((p >> 1) ^ c) << 2) | ((2 * p) & 3))); s = (f32x2v){a.x * s.x - a.y * s.y + loc.x, a.x * s.y + a.y * s.x + loc.y}; } }
            else { const f32x2v a = A32[g * NST + p];
#pragma unroll
                for (int c = 0; c < NCH; ++c) { const f32x2v s = sin[c];
                    const f32x2v loc = *(const LAS f32x2v*)(Lf + (bl * 32 + c) * 128 + ((((p >> 1) ^ c) << 2) | ((2 * p) & 3))); *(f32x2v*)(sp + (size_t)c * NGR * 256) = (f32x2v){a.x * s.x - a.y * s.y + loc.x, a.x * s.y + a.y * s.x + loc.y}; } }
            __syncthreads();
        }
    }
};
namespace ssm {
typedef short bf16x8 __attribute__((ext_vector_type(8)));
typedef float f32x16 __attribute__((ext_vector_type(16)));
constexpr int SST_OFF = 0, ZT_OFF = 65536;
__device__ __forceinline__ float gelu_fast(float x) { return x * fast_sigmoid(1.5957691216057308f * (x + 0.044715f * x * x * x)); }
__device__ __forceinline__ void ssm_unit(Frame& F, const unsigned char* tab, const float* SIN, int b, int c) {
    LAS unsigned char* L = (LAS unsigned char*)F.lds;
    const int lane = F.lane, wid = F.wave, cc = lane & 31, h = lane >> 5, t0 = b * SEQ + c * CHK;
    LAS unsigned char* sst = L + SST_OFF + wid * 8192;
    LAS bf16* ZT = (LAS bf16*)(L + ZT_OFF);
    struct GPre { f32x2v aA, aB, sA, sB; bf16x8 Bb[4], Au[2]; };
    auto gload = [&](int g, GPre& P) {
        P.aA = ((const f32x2v*)(tab + TAB_A))[g * NST + cc]; P.aB = ((const f32x2v*)(tab + TAB_A))[g * NST + 32 + cc];
#pragma unroll
        for (int st = 0; st < 4; ++st) P.Bb[st] = ((const bf16x8*)(tab + TAB_BB))[(g * 4 + st) * 64 + lane];
        const bf16* ub = F.U + ((size_t)g * T + t0) * SGC;
#pragma unroll
        for (int pt = 0; pt < 2; ++pt) { const int i = lane & 31, pos = 32 * ((i >> 2) & 1) + 16 * pt + (i & 3) + 4 * (i >> 3); P.Au[pt] = *(const bf16x8*)(ub + pos * SGC + 8 * (lane >> 5)); }
        const float* sinp = SIN + ((((size_t)b * NCH + c) * NGR + g) * 2 + h) * 128;
        P.sA = *(const f32x2v*)(sinp + 2 * cc); P.sB = *(const f32x2v*)(sinp + 2 * (32 + cc));
    };
    GPre cur; gload(wid * 4, cur);
#pragma unroll 1
    for (int gi = 0; gi < 4; ++gi) {
        const int g = wid * 4 + gi;
        GPre nxt; gload(wid * 4 + (gi < 3 ? gi + 1 : gi), nxt);
        const f32x2v aA = cur.aA, aB = cur.aB;
        bf16x8 Cm[5];
#pragma unroll
        for (int ks = 0; ks < 5; ++ks) Cm[ks] = ((const bf16x8*)(tab + TAB_CM))[(g * 5 + ks) * 64 + lane];
        const bf16* ubase = F.U + ((size_t)g * T + t0) * SGC;
        f32x16 bu[2][4];
#pragma unroll
        for (int pt = 0; pt < 2; ++pt) {
#pragma unroll
            for (int st = 0; st < 4; ++st) { f32x16 z;
#pragma unroll
                for (int r = 0; r < 16; ++r) z[r] = 0.f;
                bu[pt][st] = __builtin_amdgcn_mfma_f32_32x32x16_bf16(cur.Au[pt], cur.Bb[st], z, 0, 0, 0); } }
        f32x2v sA = cur.sA, sB = cur.sB;
#pragma unroll
        for (int pt = 0; pt < 2; ++pt) {
#pragma unroll
            for (int r = 0; r < 16; ++r) {
                sA = (f32x2v){aA.x * sA.x - aA.y * sA.y + bu[pt][0][r], aA.x * sA.y + aA.y * sA.x + bu[pt][1][r]};
                sB = (f32x2v){aB.x * sB.x - aB.y * sB.y + bu[pt][2][r], aB.x * sB.y + aB.y * sB.x + bu[pt][3][r]};
                const int R = 16 * h + r;
                *(LAS unsigned*)(sst + R * 256 + ((((cc >> 2) ^ r) << 2) | (cc & 3)) * 4) = pg::cvt_pk_bf16(sA.x, sA.y);
                *(LAS unsigned*)(sst + R * 256 + ((((8 + (cc >> 2)) ^ r) << 2) | (cc & 3)) * 4) = pg::cvt_pk_bf16(sB.x, sB.y);
            }
#pragma unroll
            for (int rb = 0; rb < 2; ++rb) { const int Rr = 16 * rb + (lane & 15); f32x4 y = (f32x4){0.f, 0.f, 0.f, 0.f};
#pragma unroll
                for (int ks = 0; ks < 4; ++ks) { const bf16x8 As = *(const LAS bf16x8*)(sst + Rr * 256 + ((((lane >> 4) + 4 * ks) ^ (lane & 15)) << 4));
                    y = __builtin_amdgcn_mfma_f32_16x16x32_bf16(As, Cm[ks], y, 0, 0, 0); }
                { const int posr = 32 * rb + 16 * pt + (lane & 15); bf16x8 A5 = (bf16x8){0, 0, 0, 0, 0, 0, 0, 0};
                  if ((lane >> 4) < 2) A5 = *(const bf16x8*)(ubase + posr * SGC + 8 * (lane >> 4));
                  y = __builtin_amdgcn_mfma_f32_16x16x32_bf16(A5, Cm[4], y, 0, 0, 0); }
#pragma unroll
                for (int i = 0; i < 4; ++i) { const int pos = 32 * rb + 16 * pt + 4 * (lane >> 4) + i; ZT[pos * DS + g * SGC + (lane & 15)] = (bf16)f2bf(gelu_fast(y[i])); }
            }
        }
        cur = nxt;
    }
    __syncthreads();
#pragma unroll
    for (int i = 0; i < 8; ++i) { const int idx = F.tid + NTHR * i, row = idx >> 6, c16 = idx & 63; *(v4u*)(F.Z + (size_t)(t0 + row) * DS + c16 * 8) = *(const LAS v4u*)(ZT + row * DS + c16 * 8); }
    __syncthreads();
}
__device__ __forceinline__ void ssm_phase(Frame& F, const unsigned char* ws) {
#pragma unroll 1
    for (int u = F.vcu; u < NB * NCH; u += F.G) ssm_unit(F, ws + OFF_TAB, (const float*)(ws + OFF_SIN), u / NCH, u % NCH);
}
}

namespace rt {
typedef float f32x16 __attribute__((ext_vector_type(16)));
constexpr int WT_OFF = 0, LG_OFF = 81920, SS_OFF = 114688, HIST_OFF = 115712, BASE_OFF = 115840;
__device__ __forceinline__ void route_phase(Frame& F) {
    LAS unsigned char* L = (LAS unsigned char*)F.lds;
    LAS bf16* Wh = (LAS bf16*)(L + WT_OFF);
    LAS bf16* Wl = Wh + 20 * DM;
    LAS float* LG = (LAS float*)(L + LG_OFF);
    LAS float* SS = (LAS float*)(L + SS_OFF);
    LAS unsigned* hist = (LAS unsigned*)(L + HIST_OFF); LAS unsigned* base = (LAS unsigned*)(L + BASE_OFF);
    const int tid = F.tid, lane = F.lane, wid = F.wave;
    if (F.vcu * 128 >= T) return;
    for (int k = tid; k < DM; k += NTHR) { const float g = F.gain2[k]; const f32x4 a = *(const f32x4*)(F.w_gr + k * 4);
        const f32x4 e0 = *(const f32x4*)(F.w_er + k * 16), e1 = *(const f32x4*)(F.w_er + k * 16 + 4), e2 = *(const f32x4*)(F.w_er + k * 16 + 8), e3 = *(const f32x4*)(F.w_er + k * 16 + 12);
#pragma unroll
        for (int o = 0; o < 4; ++o) { const float w5[5] = {a[o] * g, e0[o] * g, e1[o] * g, e2[o] * g, e3[o] * g};
#pragma unroll
            for (int q = 0; q < 5; ++q) { const int oo = 4 * q + o; const unsigned hb = f2bf(w5[q]); Wh[oo * DM + k] = (bf16)hb; Wl[oo * DM + k] = (bf16)f2bf(w5[q] - bf2f(hb)); } } }
    if (tid < 32) hist[tid] = 0u;
    __syncthreads();
    const int tb = wid >> 1, kh = wid & 1, i = lane & 31, h = lane >> 5;
#pragma unroll 1
    for (int it = F.vcu; it * 128 < T; it += F.G) {
        const int t0 = it * 128;
        { const bf16* xp = F.XB + (size_t)(t0 + 32 * tb + i) * DM + 512 * kh + 8 * h;
          const LAS bf16* whp = Wh + (i < 20 ? i : 0) * DM + 512 * kh + 8 * h; const LAS bf16* wlp = Wl + (i < 20 ? i : 0) * DM + 512 * kh + 8 * h;
          f32x16 acc;
#pragma unroll
          for (int r = 0; r < 16; ++r) acc[r] = 0.f;
          float ss = 0.f;
#pragma unroll 8
          for (int q = 0; q < 32; ++q) { const pg::u32x4 xw = *(const pg::u32x4*)(xp + 16 * q); f32x4 x0, x1; unpack8(xw, x0, x1);
              ss += ((x0[0] * x0[0] + x0[1] * x0[1]) + (x0[2] * x0[2] + x0[3] * x0[3])) + ((x1[0] * x1[0] + x1[1] * x1[1]) + (x1[2] * x1[2] + x1[3] * x1[3]));
              const pg::bf16x8 xa = __builtin_bit_cast(pg::bf16x8, xw), bh = *(const LAS pg::bf16x8*)(whp + 16 * q), bl = *(const LAS pg::bf16x8*)(wlp + 16 * q);
              acc = __builtin_amdgcn_mfma_f32_32x32x16_bf16(xa, bh, acc, 0, 0, 0); acc = __builtin_amdgcn_mfma_f32_32x32x16_bf16(xa, bl, acc, 0, 0, 0); }
          ss += __shfl_xor(ss, 32);
          if (h == 0) SS[(32 * tb + i) * 2 + kh] = ss;
#pragma unroll
          for (int r = 0; r < 16; ++r) { const int row = (r & 3) + 8 * (r >> 2) + 4 * h; LG[((32 * tb + row) * 2 + kh) * 32 + i] = acc[r]; } }
        __syncthreads();
        int cls = 0; unsigned lrank = 0; float wlo = 0.f, whi = 0.f, rs = 0.f;
        if (tid < 128) {
            float lg[20];
#pragma unroll
            for (int o = 0; o < 20; ++o) lg[o] = LG[(tid * 2) * 32 + o] + LG[(tid * 2 + 1) * 32 + o];
            rs = 1.0f / sqrtf((SS[tid * 2] + SS[tid * 2 + 1]) * (1.0f / DM) + EPS);
            float g4[4]; int gi = 0;
#pragma unroll
            for (int j = 0; j < 4; ++j) g4[j] = lg[j] * rs + F.b_gr[j];
#pragma unroll
            for (int j = 1; j < 4; ++j) if (g4[j] > g4[gi]) gi = j;
            float gs = 0.f;
#pragma unroll
            for (int j = 0; j < 4; ++j) gs += expf(g4[j] - g4[gi]);
            const float gp = 1.0f / gs;
            float le[4];
#pragma unroll
            for (int j = 0; j < 4; ++j) { float a = 0.f;
#pragma unroll
                for (int q = 0; q < 4; ++q) a = (gi == q) ? lg[4 + 4 * q + j] : a;
                le[j] = a * rs + F.b_er[gi * 4 + j]; }
            int e1 = 0;
#pragma unroll
            for (int j = 1; j < 4; ++j) if (le[j] > le[e1]) e1 = j;
            int e2 = (e1 == 0) ? 1 : 0;
#pragma unroll
            for (int j = 0; j < 4; ++j) if (j != e1 && le[j] > le[e2]) e2 = j;
            const float p2 = expf(le[e2] - le[e1]);
            const float w1 = gp / (1.0f + p2), w2 = gp * p2 / (1.0f + p2);
            const int lo = e1 < e2 ? e1 : e2, hi2 = e1 < e2 ? e2 : e1;
            wlo = e1 < e2 ? w1 : w2; whi = e1 < e2 ? w2 : w1;
            cls = gi * 6 + pair_index(lo, hi2);
            lrank = __hip_atomic_fetch_add(hist + cls, 1u, __ATOMIC_RELAXED, __HIP_MEMORY_SCOPE_WORKGROUP);
        }
        __syncthreads();
        if (tid < NCLS) { const unsigned n = hist[tid]; base[tid] = n ? xb_add(F.ctl + CW_CNT + 64 * tid, n) : 0u; hist[tid] = 0u; }
        __syncthreads();
        if (tid < 128) { const int t = t0 + tid; const unsigned rank = base[cls] + lrank;
            F.LIST[(size_t)cls * T + rank] = t; F.TOKC[t] = cls; F.TOKW[2 * t] = wlo; F.TOKW[2 * t + 1] = whi; F.RSTD2[t] = rs; }
        __syncthreads();
    }
}
}

__global__ void __launch_bounds__(NTHR, 2) mk_fwd(Args args) {
    extern __shared__ __attribute__((aligned(16))) unsigned char lds[];
    Frame F;
    F.lds = lds; F.tid = threadIdx.x; F.lane = F.tid & 63; F.wave = __builtin_amdgcn_readfirstlane(F.tid >> 6);
    F.G = gridDim.x; { const int bx = blockIdx.x; F.vcu = (F.G % 8 == 0) ? (bx % 8) * (F.G / 8) + bx / 8 : bx; }
    unsigned char* ws = args.ws;
    F.x = args.in[0]; F.gain1 = args.in[1]; F.w_in = args.in[2]; F.b_gate = args.in[3]; F.q_gain = args.in[4]; F.k_gain = args.in[5]; F.rel_bias = args.in[6];
    F.lam_re = args.in[7]; F.lam_im = args.in[8]; F.log_step = args.in[9]; F.sb_re = args.in[10]; F.sb_im = args.in[11]; F.sc_re = args.in[12]; F.sc_im = args.in[13];
    F.ssm_d = args.in[14]; F.w_glu = args.in[15]; F.b_glu = args.in[16]; F.w_branch = args.in[17]; F.w_out = args.in[18]; F.gain2 = args.in[19];
    F.w_gr = args.in[20]; F.b_gr = args.in[21]; F.w_er = args.in[22]; F.b_er = args.in[23]; F.w_eg = args.in[24]; F.w_eu = args.in[25]; F.w_ed = args.in[26];
    F.out = args.out; F.ctl = (unsigned*)(ws + OFF_CTL);
    F.XB = (bf16*)(ws + OFF_XB); F.Q = (bf16*)(ws + OFF_Q); F.K = (bf16*)(ws + OFF_K); F.V = (bf16*)(ws + OFF_V); F.U = (bf16*)(ws + OFF_U); F.GT = (bf16*)(ws + OFF_G);
    F.YA = (bf16*)(ws + OFF_YA); F.Z = (bf16*)(ws + OFF_Z); F.YS = (bf16*)(ws + OFF_YS); F.MG = (bf16*)(ws + OFF_MERGED); F.HID = (bf16*)(ws + OFF_HID);
    F.LIST = (int*)(ws + OFF_LIST); F.TOKC = (int*)(ws + OFF_TOKC); F.TOKW = (float*)(ws + OFF_TOKW); F.RSTD1 = (float*)(ws + OFF_RSTD1); F.RSTD2 = (float*)(ws + OFF_RSTD2);
    for (int u = F.tid; u < (LDS_BYTES - LDSCTL_OFF) / 4; u += NTHR) ((LAS unsigned*)((LAS unsigned char*)lds + LDSCTL_OFF))[u] = 0u;
    __syncthreads();
    XcdBarrier bar = xcd_barrier_post(F.ctl + CW_BAR, (volatile LAS unsigned*)((LAS unsigned char*)lds + MISC_OFF) + 8);
    const int lo = args.ph_lo, hi = args.ph_hi;
#define IN(k) (lo <= (k) && (k) < hi)
#define SEAM(k) do { if (IN(k) && IN((k) + 1)) xcd_barrier(bar); } while (0)
    if (IN(0)) {
    if (F.wave < 4) ph_xconv(F, 4);
    else { ph_weights(F, ws, true, F.vcu, F.G, 4, 4); ph_ssmtab(F, ws, 256); }
    }
    SEAM(0);
    if (IN(1)) {
    { SchedPlain S; S.o.init(T, DIN, F.G, (int)blockIdx.x); S.A = (const char*)F.XB; S.B = (const char*)(ws + OFF_WIN); S.lda_b = DM * 2; S.ldb_b = DM * 2; S.nseg = 1; S.segA = 0; S.segB = 0; S.khalf_b = DM;
      EpiInproj E{F.Q, F.K, F.V, F.U, F.GT, F.RSTD1, F.q_gain, F.k_gain, F.b_gate};
      pg::gemm_phase<EpiInproj, SchedPlain, false>((LAS unsigned char*)lds, DM, DM * 2, DM * 2, S, E); }
    }
    SEAM(1);
    if (IN(2)) {
    { SchedSloc S; S.U = (const char*)F.U; S.W = (const char*)(ws + OFF_WSSM); S.c = (int)blockIdx.x;
      EpiSloc E{(float*)(ws + OFF_SIN), (const f32x2v*)(ws + OFF_TAB + TAB_A32), (const f32x2v*)(ws + OFF_TAB + TAB_A64)};
      pg::gemm_phase<EpiSloc, SchedSloc, false>((LAS unsigned char*)lds, 1024, 2048, 2048, S, E);
      __syncthreads(); }
    att::attn_phase(F);
    ph_weights(F, ws, false, F.vcu, F.G); __syncthreads();
    }
    SEAM(2);
    if (IN(3)) {
    ssm::ssm_phase(F, ws);
    }
    SEAM(3);
    if (IN(4)) {
    { SchedPlain S; S.o.init(T, DS, F.G, (int)blockIdx.x); S.A = (const char*)F.Z; S.B = (const char*)(ws + OFF_WGLU); S.lda_b = DS * 2; S.ldb_b = DS * 2; S.nseg = 1; S.segA = 0; S.segB = 0; S.khalf_b = DS;
      EpiGlu E{F.Z, F.YS, F.b_glu};
      pg::gemm_phase<EpiGlu, SchedPlain, false>((LAS unsigned char*)lds, DS, DS * 2, DS * 2, S, E); }
    }
    SEAM(4);
    if (IN(5)) {
    { SchedPlain S; S.o.init(T, DM, F.G, (int)blockIdx.x); S.A = (const char*)F.YA; S.B = (const char*)(ws + OFF_WA); S.lda_b = DA * 2; S.ldb_b = DA * 2; S.nseg = 2; S.khalf_b = DA;
      S.segA = (size_t)((const char*)F.YS - (const char*)F.YA); S.segB = OFF_WS - OFF_WA;
      EpiBranch E{(const unsigned char*)F.GT, F.MG};
      pg::gemm_phase<EpiBranch, SchedPlain, false>((LAS unsigned char*)lds, DA, DA * 2, DA * 2, S, E); }
    }
    SEAM(5);
    if (IN(6)) {
    { SchedPlain S; S.o.init(T, DM, F.G, (int)blockIdx.x); S.A = (const char*)F.MG; S.B = (const char*)(ws + OFF_WOUT); S.lda_b = DM * 2; S.ldb_b = DM * 2; S.nseg = 1; S.segA = 0; S.segB = 0; S.khalf_b = DM;
      EpiOut E{F.XB};
      pg::gemm_phase<EpiOut, SchedPlain, false>((LAS unsigned char*)lds, DM, DM * 2, DM * 2, S, E); }
    }
    SEAM(6);
    if (IN(7)) {
    rt::route_phase(F);
    }
    SEAM(7);
    if (IN(8)) {
    { moe_build_tab(F);
      SchedMoe S; S.tab = (const LAS int*)((LAS unsigned char*)lds + MOE_TAB_OFF); S.G = F.G; S.c = F.vcu; S.nseg = 1; S.mode = 0; S.A = (const char*)F.XB; S.B = (const char*)(ws + OFF_WGU); S.LIST = F.LIST;
      EpiGateUp E{F.HID, F.RSTD2, F.TOKW};
      pg::gemm_phase<EpiGateUp, SchedMoe, true>((LAS unsigned char*)lds, DM, DM * 2, DM * 2, S, E); }
    }
    SEAM(8);
    if (IN(9)) {
    { moe_build_tab(F);
      SchedMoe S; S.tab = (const LAS int*)((LAS unsigned char*)lds + MOE_TAB_OFF); S.G = F.G; S.c = F.vcu; S.nseg = 1; S.mode = 1; S.A = (const char*)F.HID; S.B = (const char*)(ws + OFF_WD); S.LIST = F.LIST;
      EpiDown E{F.out, F.XB};
      pg::gemm_phase<EpiDown, SchedMoe, true, true>((LAS unsigned char*)lds, 2 * DEX, 512 * 2, DEX * 2, S, E); }
    }
#undef IN
#undef SEAM
}

extern "C" void kernel_launch(void* const* d_in, const int* in_sizes, int n_in, void* d_out, int out_size, void* d_ws, size_t ws_size, hipStream_t stream) {
    static int grid = 0;
    if (grid == 0) {
        if (n_in != 27 || in_sizes[0] != T * DM || out_size != T * DM || ws_size < WS_END) { fprintf(stderr, "kernel_launch: unexpected shapes (n_in %d, in0 %d, out %d, ws %zu)\n", n_in, n_in > 0 ? in_sizes[0] : -1, out_size, ws_size); grid = -1; return; }
        int dev = 0, cus = 0;
        if (hipGetDevice(&dev) != hipSuccess || hipDeviceGetAttribute(&cus, hipDeviceAttributeMultiprocessorCount, dev) != hipSuccess) { grid = -1; return; }
        if (hipFuncSetAttribute((const void*)mk_fwd, hipFuncAttributeMaxDynamicSharedMemorySize, LDS_BYTES) != hipSuccess) { fprintf(stderr, "kernel_launch: hipFuncSetAttribute failed\n"); grid = -1; return; }
        int per_cu = 0;
        if (hipOccupancyMaxActiveBlocksPerMultiprocessor(&per_cu, (const void*)mk_fwd, NTHR, LDS_BYTES) != hipSuccess || per_cu < 1) fprintf(stderr, "kernel_launch: occupancy query reports %d\n", per_cu);
        (void)hipGetLastError();
        grid = cus;
    }
    if (grid < 0) return;
    (void)hipMemsetAsync((char*)d_ws + OFF_CTL, 0, CTL_ZERO_BYTES, stream);
    Args a{};
    for (int i = 0; i < 27; ++i) a.in[i] = (const float*)d_in[i];
    a.out = (float*)d_out; a.ws = (unsigned char*)d_ws; a.ph_lo = 0; a.ph_hi = 10;
    hipLaunchKernelGGL(mk_fwd, dim3(grid), dim3(NTHR), LDS_BYTES, stream, a);
}
```

```cpp
#include <hip/hip_runtime.h>
#include <cstdio>
#include <cstdint>
#include <cmath>

constexpr int DM = 1024, NB = 16, SEQ = 2048, T = NB * SEQ, CHK = 64, NCH = SEQ / CHK, NH = 8, HD = 64, DA = 512, DS = 512;
constexpr int SGC = 16, NGR = 32, NST = 64, DIN = 4096, NEX = 16, DEX = 256, NREL = 320, LEFT = 8, NCLS = 24;
constexpr float EPS = 1e-6f;
constexpr float LOG2E = 1.4426950408889634f;
constexpr float QSCALE = 0.125f * LOG2E;
constexpr int NWAVES = 8, NTHR = 512;

constexpr size_t MiB = 1u << 20;
constexpr size_t OFF_CTL = 0, CTL_ZERO_BYTES = 1 * MiB;
constexpr size_t OFF_TAB = 1 * MiB;
constexpr size_t OFF_LIST = 56 * MiB;
constexpr size_t OFF_TOKC = 59 * MiB;
constexpr size_t OFF_TOKW = OFF_TOKC + 128 * 1024;
constexpr size_t OFF_RSTD1 = OFF_TOKW + 256 * 1024;
constexpr size_t OFF_RSTD2 = OFF_RSTD1 + 128 * 1024;
constexpr size_t OFF_XB = 64 * MiB;
constexpr size_t OFF_XB8 = 416 * MiB;
constexpr size_t OFF_W8 = 6 * MiB;
constexpr float W8_SCALE = 64.0f, MG8_SCALE = 8.0f;
constexpr size_t OFF_Q = 128 * MiB, OFF_K = 160 * MiB, OFF_V = 192 * MiB, OFF_U = 224 * MiB;
constexpr size_t OFF_G = 256 * MiB;
constexpr size_t OFF_YA = 416 * MiB, OFF_Z = 448 * MiB;
constexpr size_t OFF_YS = OFF_U, OFF_MERGED = OFF_Q, OFF_HID = OFF_V;
constexpr size_t WS_END = 480 * MiB;
constexpr int CW_CNT = 1024;
constexpr int CW_BAR = 4096;
constexpr int CW_ATTQ = 3072;
constexpr int CW_TILE = 16384;

constexpr int LDS_BYTES = 147456, LDSCTL_OFF = 131072, MISC_OFF = LDSCTL_OFF + 320;

#define GAS __attribute__((address_space(1)))
#define LAS __attribute__((address_space(3)))
typedef unsigned short bf16;
typedef unsigned v4u __attribute__((ext_vector_type(4)));
typedef unsigned v2u __attribute__((ext_vector_type(2)));
__device__ __forceinline__ unsigned pk4f8(float a, float b, float c, float d) { int w = __builtin_amdgcn_cvt_pk_fp8_f32(a, b, 0, false); return (unsigned)__builtin_amdgcn_cvt_pk_fp8_f32(c, d, w, true); }
typedef float f32x4 __attribute__((ext_vector_type(4)));

__device__ __forceinline__ unsigned f2bf(float f) { unsigned u = __builtin_bit_cast(unsigned, f); return (u + 0x7fffu + ((u >> 16) & 1u)) >> 16; }
__device__ __forceinline__ float bf2f(unsigned b) { return __builtin_bit_cast(float, (b & 0xffffu) << 16); }
__device__ __forceinline__ float bflo(unsigned w) { return __builtin_bit_cast(float, w << 16); }
__device__ __forceinline__ float bfhi(unsigned w) { return __builtin_bit_cast(float, w & 0xffff0000u); }
__device__ __forceinline__ unsigned pk2(float lo, float hi) { return f2bf(lo) | (f2bf(hi) << 16); }
__device__ __forceinline__ float wave_sum(float v) {
#pragma unroll
    for (int o = 1; o < 64; o <<= 1) v += __shfl_xor(v, o);
    return v;
}
__device__ __forceinline__ float sigmoidf_(float x) { return 1.0f / (1.0f + __expf(-x)); }
__device__ __forceinline__ float gelu_tanh(float x) { const float u = 0.7978845608028654f * (x + 0.044715f * x * x * x); return 0.5f * x * (1.0f + tanhf(u)); }

#define XB_TMO      128
#define XB_XCNT(j)  (256  + 64 * (j))
#define XB_XSUB(j)  (1280 + 64 * (j))
#define XB_XGEN(j)  (2304 + 64 * (j))
#define XB_TOP      3328
#define XB_TOPGEN   3392
#define XCD_BAR_WORDS 3456
#define XB_SPIN_CAP (1u << 22)
__device__ __forceinline__ unsigned xb_ld(unsigned* p)              { return __hip_atomic_load(p, __ATOMIC_RELAXED, __HIP_MEMORY_SCOPE_AGENT); }
__device__ __forceinline__ unsigned xb_add(unsigned* p, unsigned v) { return __hip_atomic_fetch_add(p, v, __ATOMIC_RELAXED, __HIP_MEMORY_SCOPE_AGENT); }
__device__ __forceinline__ unsigned xb_xcc_id() { return (unsigned)__builtin_amdgcn_s_getreg((3 << 11) | 20) & 0xFu; }
#define XB_SPIN(cond, bar) do { unsigned _sp = 0; while (cond) { __builtin_amdgcn_s_sleep(1); \
    if ((++_sp & 255u) == 0u) { if (xb_ld(&(bar)[XB_TMO])) break; if (_sp > XB_SPIN_CAP) { atomicAdd(&(bar)[XB_TMO], 1u); break; } } } } while (0)
struct XcdBarrier { unsigned* bar; unsigned x; volatile LAS unsigned* st; };
__device__ __forceinline__ XcdBarrier xcd_barrier_post(unsigned* bar, volatile LAS unsigned* st) {
    XcdBarrier b; b.bar = bar; b.x = xb_xcc_id(); b.st = st;
    if (threadIdx.x == 0) (void)xb_add(&bar[XB_XCNT(b.x)], 1u);
    return b;
}
__device__ __forceinline__ void xcd_barrier_complete(unsigned* bar, unsigned x, unsigned& nloc, unsigned& nx) {
    const unsigned G = gridDim.x * gridDim.y * gridDim.z;
    unsigned sum, cnt, mine, sp = 0u;
    for (;;) {
        sum = 0u; cnt = 0u; mine = 0u;
#pragma unroll
        for (unsigned j = 0; j < 16; ++j) { const unsigned c = xb_ld(&bar[XB_XCNT(j)]); sum += c; cnt += (c > 0u) ? 1u : 0u; mine = (j == x) ? c : mine; }
        if (sum == G) break;
        __builtin_amdgcn_s_sleep(1);
        if ((++sp & 255u) == 0u) { if (xb_ld(&bar[XB_TMO])) break; if (sp > XB_SPIN_CAP) { atomicAdd(&bar[XB_TMO], 1u); break; } }
    }
    nloc = mine > 0u ? mine : 1u; nx = cnt > 0u ? cnt : 1u;
}
template <class Work>
__device__ __forceinline__ void xcd_barrier_w(const XcdBarrier& b, const Work& work) {
    asm volatile("s_waitcnt vmcnt(0)" ::: "memory");
    __syncthreads();
    if (threadIdx.x >= 64) work();
    if (threadIdx.x == 0) {
        unsigned* bar = b.bar;
        __builtin_amdgcn_s_waitcnt(0);
        unsigned nloc = b.st[0], nx = b.st[1];
        if (nloc == 0u) { xcd_barrier_complete(bar, b.x, nloc, nx); b.st[0] = nloc; b.st[1] = nx; }
        const unsigned old = xb_add(&bar[XB_XSUB(b.x)], 1u);
        const unsigned gen = old / nloc;
        if (old + 1u == (gen + 1u) * nloc) {
            __builtin_amdgcn_fence(__ATOMIC_RELEASE, "agent");
            asm volatile("s_waitcnt vmcnt(0)" ::: "memory");
            const unsigned og = xb_add(&bar[XB_TOP], 1u);
            const unsigned tg = og / nx;
            if (og + 1u == (tg + 1u) * nx) xb_add(&bar[XB_TOPGEN], 1u);
            else XB_SPIN(xb_ld(&bar[XB_TOPGEN]) == tg, bar);
            __builtin_amdgcn_fence(__ATOMIC_ACQUIRE, "agent");
            xb_add(&bar[XB_XGEN(b.x)], 1u);
            asm volatile("s_waitcnt vmcnt(0)" ::: "memory");
        } else {
            __builtin_amdgcn_fence(__ATOMIC_ACQUIRE, "agent");
            XB_SPIN(xb_ld(&bar[XB_XGEN(b.x)]) == gen, bar);
            asm volatile("s_waitcnt vmcnt(0)" ::: "memory");
        }
    }
    __syncthreads();
}
__device__ __forceinline__ void xcd_barrier(const XcdBarrier& b) { xcd_barrier_w(b, [] {}); }

struct Args { const float* in[27]; float* out; unsigned char* ws; int ph_lo, ph_hi; };
struct Frame {
    unsigned char* lds; int tid, lane, wave, vcu, G;
    const float* x; const float* gain1; const float* w_in; const float* b_gate; const float* q_gain; const float* k_gain; const float* rel_bias;
    const float *lam_re, *lam_im, *log_step, *sb_re, *sb_im, *sc_re, *sc_im, *ssm_d, *w_glu, *b_glu, *w_branch, *w_out, *gain2, *w_gr, *b_gr, *w_er, *b_er, *w_eg, *w_eu, *w_ed;
    float* out; unsigned* ctl;
    bf16 *XB, *Q, *K, *V, *U, *GT, *YA, *Z, *YS, *MG, *HID; unsigned char* XB8;
    int* LIST; int* TOKC; float* TOKW; float* RSTD1; float* RSTD2;
};

__device__ __forceinline__ float dpp_sum16(float v) {
    v += __builtin_bit_cast(float, __builtin_amdgcn_mov_dpp(__builtin_bit_cast(int, v), 0xB1, 0xF, 0xF, true));
    v += __builtin_bit_cast(float, __builtin_amdgcn_mov_dpp(__builtin_bit_cast(int, v), 0x4E, 0xF, 0xF, true));
    v += __builtin_bit_cast(float, __builtin_amdgcn_mov_dpp(__builtin_bit_cast(int, v), 0x141, 0xF, 0xF, true));
    v += __builtin_bit_cast(float, __builtin_amdgcn_mov_dpp(__builtin_bit_cast(int, v), 0x140, 0xF, 0xF, true));
    return v;
}
__device__ __forceinline__ void ph_xconv(Frame& F, int nwv) {
    const int gw = F.vcu * nwv + F.wave, NGW = F.G * nwv, lr = F.lane & 15, rsub = F.lane >> 4;
    f32x4 a[8], b[8];
    int m4 = gw;
    if (m4 < T / 4) { const f32x4* xr = (const f32x4*)(F.x + (size_t)(m4 * 4 + rsub) * DM + 8 * lr);
#pragma unroll
        for (int j = 0; j < 8; ++j) { a[j] = __builtin_nontemporal_load(xr + 32 * j); b[j] = __builtin_nontemporal_load(xr + 32 * j + 1); } }
    for (; m4 < T / 4; m4 += NGW) {
        const int m = m4 * 4 + rsub, mn4 = m4 + NGW;
        f32x4 a2[8], b2[8];
        if (mn4 < T / 4) { const f32x4* xr = (const f32x4*)(F.x + (size_t)(mn4 * 4 + rsub) * DM + 8 * lr);
#pragma unroll
            for (int j = 0; j < 8; ++j) { a2[j] = __builtin_nontemporal_load(xr + 32 * j); b2[j] = __builtin_nontemporal_load(xr + 32 * j + 1); } }
        float s = 0.f;
#pragma unroll
        for (int j = 0; j < 8; ++j) s += ((a[j].x * a[j].x + a[j].y * a[j].y) + (a[j].z * a[j].z + a[j].w * a[j].w)) + ((b[j].x * b[j].x + b[j].y * b[j].y) + (b[j].z * b[j].z + b[j].w * b[j].w));
        s = dpp_sum16(s);
        if (lr == 0) F.RSTD1[m] = 1.0f / sqrtf(s * (1.0f / DM) + EPS);
        v4u* o = (v4u*)(F.XB + (size_t)m * DM + 8 * lr);
#pragma unroll
        for (int j = 0; j < 8; ++j) o[16 * j] = (v4u){pk2(a[j].x, a[j].y), pk2(a[j].z, a[j].w), pk2(b[j].x, b[j].y), pk2(b[j].z, b[j].w)};
        v2u* o8 = (v2u*)(F.XB8 + (size_t)m * DM + 8 * lr);
#pragma unroll
        for (int j = 0; j < 8; ++j) o8[16 * j] = (v2u){pk4f8(a[j].x, a[j].y, a[j].z, a[j].w), pk4f8(b[j].x, b[j].y, b[j].z, b[j].w)};
        if (mn4 < T / 4) {
#pragma unroll
            for (int j = 0; j < 8; ++j) { a[j] = a2[j]; b[j] = b2[j]; } }
    }
}

__device__ __forceinline__ int pair_index(int lo, int hi) { return lo == 0 ? hi - 1 : (lo == 1 ? hi + 1 : 5); }
__device__ __forceinline__ void pair_decode(int pr, int& lo, int& hi) { lo = pr < 3 ? 0 : (pr < 5 ? 1 : 2); hi = pr < 3 ? pr + 1 : (pr < 5 ? pr - 1 : 3); }
namespace pg {
typedef short bf16x8 __attribute__((ext_vector_type(8)));
typedef unsigned u32x4 __attribute__((ext_vector_type(4)));
typedef unsigned u32x2 __attribute__((ext_vector_type(2)));
typedef float f32x2 __attribute__((ext_vector_type(2)));
typedef int i32x4 __attribute__((ext_vector_type(4)));
typedef int i32x8 __attribute__((ext_vector_type(8)));
constexpr int BM = 256, BK = 64, HALF = 128, HTB = HALF * BK * 2, STAGE_BYTES = 8 * HTB, NXCD = 8, WGM = 8;
__host__ __device__ __forceinline__ int lds_byte(int r, int c) { const int st = (r >> 4) * 2 + (c >> 5), rr = r & 15, cc = c & 31, ob = rr * 64 + cc * 2; return st * 1024 + (ob ^ (((ob >> 9) & 1) << 5)); }
__host__ __device__ __forceinline__ void stage_rc(int b, int& R, int& C) { const int st = b / 1024, sb = b % 1024, swz = sb ^ (((sb >> 9) & 1) << 5); R = (st >> 1) * 16 + swz / 64; C = (st & 1) * 32 + (swz % 64) / 2; }
__host__ __device__ __forceinline__ int perm32(int rho) { const int n = rho >> 4, i = rho & 15; return 8 * (i >> 2) + 4 * n + (i & 3); }
typedef __bf16 bf16x2_t __attribute__((ext_vector_type(2)));
__device__ __forceinline__ unsigned cvt_pk_bf16(float lo, float hi) { f32x2 v = {lo, hi}; bf16x2_t b = __builtin_convertvector(v, bf16x2_t); return __builtin_bit_cast(unsigned, b); }

enum { UF_FIRST = 1, UF_LAST = 2 };
struct Unit { const char* A; const char* B; const int* list; int pm, pn, flags, cnt, aux; };

struct TileOrder {
    int nM, nN, nwg, G, c;
    __device__ __forceinline__ void init(int M, int N, int G_, int c_) { nM = M / BM; nN = N / BM; nwg = nM * nN; G = G_; c = c_; }
    __device__ __forceinline__ bool tile(int i, int& pm, int& pn) const {
        const long L = (long)i * G + c; if (L >= nwg) return false;
        int wgid = (int)L; { const int q = nwg / NXCD, r = nwg % NXCD, xcd = wgid % NXCD, off = wgid / NXCD; wgid = (xcd < r ? xcd * (q + 1) : r * (q + 1) + (xcd - r) * q) + off; }
        const int nig = WGM * nN, gid = wgid / nig, fm = gid * WGM, gsz = (nM - fm) < WGM ? (nM - fm) : WGM;
        pm = fm + ((wgid % nig) % gsz); pn = (wgid % nig) / gsz; return true;
    }
};

typedef f32x4 Acc[2][2][4][2];
template <class Epi, class Sched, bool GATHER, bool BSPLIT = false, bool F8 = false>
__device__ __forceinline__ void gemm_phase(LAS unsigned char* lds, const int K, const int lda_b, const int ldb_b, const Sched& S, const Epi& E) {
    const int tid = threadIdx.x, wid = __builtin_amdgcn_readfirstlane(tid >> 6), lane = tid & 63, wr = wid >> 2, wc = wid & 3, fr = lane & 15, fq = lane >> 4;
    const int nt = K / BK;
    unsigned voffB[2], oA[2][2], noA[2][2]; int RA[2], CA[2];
#pragma unroll
    for (int i = 0; i < 2; ++i) { int R, C; stage_rc(tid * 16 + i * 8192, R, C); const int Rb = Epi::PERM ? ((R & ~31) + perm32(R & 31)) : R;
        RA[i] = R; CA[i] = C; voffB[i] = (unsigned)(Rb * ldb_b + C * 2);
        oA[0][i] = (unsigned)(R * lda_b + C * 2); oA[1][i] = (unsigned)((R + HALF) * lda_b + C * 2); noA[0][i] = oA[0][i]; noA[1][i] = oA[1][i]; }
    const size_t kstep = (size_t)(BK * 2);
    const size_t hstepB = (size_t)HALF * ldb_b, hstepA = (size_t)HALF * lda_b;
    const unsigned ldsw = (unsigned)wid * 1024u, lds0 = (unsigned)__builtin_amdgcn_readfirstlane((int)(unsigned)(__UINTPTR_TYPE__)lds);
    const int aoff = lds_byte(wr * 64 + fr, fq * 8), boff = lds_byte(wc * 32 + fr, fq * 8);
#define PG_SA(b, h) (((b) * 2 + (h)) * HTB)
#define PG_SB(b, h) ((4 + (b) * 2 + (h)) * HTB)
#define PG_GLDS(gbase, voff, ldsaddr) do { unsigned sv_; asm volatile("s_mov_b32 %0, m0\n\ts_mov_b32 m0, %3\n\ts_nop 0\n\tglobal_load_lds_dwordx4 %1, %2\n\ts_mov_b32 m0, %0" : "=&s"(sv_) : "v"(voff), "s"((const char*)(gbase)), "s"((unsigned)(ldsaddr)) : "memory"); } while (0)
#define PG_STAGE_B(bufoff, gbase) do { _Pragma("unroll") for (int _i = 0; _i < 2; ++_i) { \
        if constexpr (F8) PG_GLDS(gbase, voffB[_i], lds0 + (bufoff) + ldsw + _i * 8192); \
        else __builtin_amdgcn_global_load_lds((const unsigned*)((const char*)(gbase) + voffB[_i]), (LAS unsigned*)(lds + (bufoff) + ldsw + _i * 8192), 16, 0, 0); } } while (0)
#define PG_STAGE_A(bufoff, gbase, o0, o1) do { \
        if constexpr (F8) { PG_GLDS(gbase, o0, lds0 + (bufoff) + ldsw); PG_GLDS(gbase, o1, lds0 + (bufoff) + ldsw + 8192); } else { \
        __builtin_amdgcn_global_load_lds((const unsigned*)((const char*)(gbase) + (o0)), (LAS unsigned*)(lds + (bufoff) + ldsw), 16, 0, 0); \
        __builtin_amdgcn_global_load_lds((const unsigned*)((const char*)(gbase) + (o1)), (LAS unsigned*)(lds + (bufoff) + ldsw + 8192), 16, 0, 0); } } while (0)
#define PG_STAGE_AH(bufoff, gbase, o0, o1) do { if constexpr (F8 && !GATHER) { PG_STAGE_A(bufoff, (const char*)(gbase) + hstepA, oA[0][0], oA[0][1]); } else { PG_STAGE_A(bufoff, gbase, o0, o1); } } while (0)
#define PG_LDA(dst, b, h) do { _Pragma("unroll") for (int m = 0; m < 4; ++m) _Pragma("unroll") for (int k = 0; k < 2; ++k) dst[m][k] = *(const LAS bf16x8*)(lds + PG_SA(b, h) + aoff + m * 2048 + k * 1024); } while (0)
#define PG_LDB(dst, b, h) do { _Pragma("unroll") for (int n = 0; n < 2; ++n) _Pragma("unroll") for (int k = 0; k < 2; ++k) dst[n][k] = *(const LAS bf16x8*)(lds + PG_SB(b, h) + boff + n * 2048 + k * 1024); } while (0)
#define PG_CAT8(x0, x1) __builtin_shufflevector(__builtin_bit_cast(i32x4, x0), __builtin_bit_cast(i32x4, x1), 0, 1, 2, 3, 4, 5, 6, 7)
#define PG_MMA(ai, bj, At, Bt) do { __builtin_amdgcn_s_setprio(1); _Pragma("unroll") for (int m = 0; m < 4; ++m) _Pragma("unroll") for (int n = 0; n < 2; ++n) { \
        if constexpr (F8) { const i32x8 b8_ = PG_CAT8(Bt[n][0], Bt[n][1]), a8_ = PG_CAT8(At[m][0], At[m][1]); \
            asm volatile("v_mfma_f32_16x16x128_f8f6f4 %0, %1, %2, %0" : "+v"(acc[ai][bj][m][n]) : "v"(b8_), "v"(a8_)); }   \
        else { _Pragma("unroll") for (int k = 0; k < 2; ++k) acc[ai][bj][m][n] = __builtin_amdgcn_mfma_f32_16x16x32_bf16(Bt[n][k], At[m][k], acc[ai][bj][m][n], 0, 0, 0); } } \
        __builtin_amdgcn_s_setprio(0); } while (0)
#define PG_WAIT_V(n) asm volatile("s_waitcnt vmcnt(" #n ")" ::: "memory")
#define PG_WAIT_L(n) asm volatile("s_waitcnt lgkmcnt(" #n ")" ::: "memory")
#define PG_BAR __builtin_amdgcn_s_barrier()
#define PG_SCHED __builtin_amdgcn_sched_barrier(0)
#define PG_GATHER_OFFS(dst, U) do { if constexpr (GATHER) { _Pragma("unroll") for (int _h = 0; _h < 2; ++_h) _Pragma("unroll") for (int _i = 0; _i < 2; ++_i) { \
        const int _r = _h * HALF + RA[_i]; const int _row = (U).list[_r < (U).cnt ? _r : 0]; dst[_h][_i] = (unsigned)_row * (unsigned)lda_b + (unsigned)(CA[_i] * 2); } } } while (0)
    Unit cur, nxt; int ui = 0;
    if (!S.next(0, cur)) return;
    S.ready(cur);
    PG_GATHER_OFFS(oA, cur);
    Acc acc;
#pragma unroll
    for (int a = 0; a < 2; ++a)
#pragma unroll
        for (int b = 0; b < 2; ++b)
#pragma unroll
            for (int m = 0; m < 4; ++m)
#pragma unroll
                for (int n = 0; n < 2; ++n) acc[a][b][m][n] = (f32x4){0.f, 0.f, 0.f, 0.f};
    bf16x8 At[4][2], B0[2][2], B1[2][2];
    const char* cA = cur.A; const char* cB = cur.B;
    PG_STAGE_B(PG_SB(0, 0), cB); PG_STAGE_B(PG_SB(0, 1), cB + hstepB); PG_STAGE_A(PG_SA(0, 0), cA, oA[0][0], oA[0][1]); PG_STAGE_AH(PG_SA(0, 1), cA, oA[1][0], oA[1][1]);
    if (wr == 1) PG_BAR;
    PG_WAIT_V(2); PG_BAR;
    PG_STAGE_B(PG_SB(1, 0), cB + kstep); PG_STAGE_A(PG_SA(1, 0), cA + kstep, oA[0][0], oA[0][1]); PG_STAGE_B(PG_SB(1, 1), cB + hstepB + kstep);
    PG_WAIT_V(6); PG_BAR;
    for (;;) {
        const bool has_next = S.next(ui + 1, nxt);
        const char* nA = has_next ? nxt.A : cA; const char* nB = has_next ? nxt.B : cB;
        if constexpr (GATHER) { if (has_next) { PG_GATHER_OFFS(noA, nxt); } else {
#pragma unroll
            for (int h = 0; h < 2; ++h)
#pragma unroll
                for (int i = 0; i < 2; ++i) noA[h][i] = oA[h][i]; } }
#pragma unroll 1
        for (int t = 0; t < nt; t += 2) {
            const bool last = (t == nt - 2); if (last && has_next) S.ready(nxt);
            const char* a1 = cA + (size_t)(t + 1) * kstep;
            const char* a2 = last ? nA : cA + (size_t)(t + 2) * kstep; const char* b2 = last ? nB : cB + (size_t)(t + 2) * kstep;
            if constexpr (BSPLIT) { if (!last && (t + 2) >= (nt >> 1)) b2 = cB + cur.aux + (size_t)(t + 2 - (nt >> 1)) * kstep; }
            const char* a3 = a2 + kstep; const char* b3 = b2 + kstep;
            unsigned q00 = oA[0][0], q01 = oA[0][1], q10 = oA[1][0], q11 = oA[1][1];
            if constexpr (GATHER) { if (last) { q00 = noA[0][0]; q01 = noA[0][1]; q10 = noA[1][0]; q11 = noA[1][1]; } }
            PG_LDB(B0, 0, 0); PG_LDB(B1, 0, 1); PG_SCHED; PG_LDA(At, 0, 0); PG_STAGE_AH(PG_SA(1, 1), a1, oA[1][0], oA[1][1]);
            PG_WAIT_V(8); PG_WAIT_L(0); PG_BAR; PG_MMA(0, 0, At, B0); PG_MMA(0, 1, At, B1); PG_BAR; PG_SCHED;
            PG_LDA(At, 0, 1); PG_STAGE_B(PG_SB(0, 0), b2); PG_STAGE_B(PG_SB(0, 1), b2 + hstepB); PG_STAGE_A(PG_SA(0, 0), a2, q00, q01);
            PG_WAIT_V(8); PG_WAIT_L(0); PG_BAR; PG_MMA(1, 0, At, B0); PG_MMA(1, 1, At, B1); PG_BAR; PG_SCHED;
            PG_LDB(B0, 1, 0); PG_LDB(B1, 1, 1); PG_SCHED; PG_LDA(At, 1, 0); PG_STAGE_AH(PG_SA(0, 1), a2, q10, q11);
            PG_WAIT_V(8); PG_WAIT_L(0); PG_BAR; PG_MMA(0, 0, At, B0); PG_MMA(0, 1, At, B1); PG_BAR; PG_SCHED;
            PG_LDA(At, 1, 1); PG_STAGE_B(PG_SB(1, 0), b3); PG_STAGE_B(PG_SB(1, 1), b3 + hstepB); PG_STAGE_A(PG_SA(1, 0), a3, q00, q01);
            PG_WAIT_V(8); PG_WAIT_L(0); PG_BAR; PG_MMA(1, 0, At, B0); PG_MMA(1, 1, At, B1); PG_BAR; PG_SCHED;
        }
        if constexpr (F8) asm volatile("s_nop 15\n\ts_nop 15\n\ts_nop 15" ::: "memory");
        if (wr == 0) PG_BAR;
        if constexpr (!Epi::AFTER_DRAIN) { if (cur.flags & UF_LAST) E(acc, cur, wr, wc, fr, fq); else E.mid(acc, cur, wr, wc, fr, fq); }
        if (!has_next) break;
        if (nxt.flags & UF_FIRST) {
#pragma unroll
            for (int a = 0; a < 2; ++a)
#pragma unroll
                for (int b = 0; b < 2; ++b)
#pragma unroll
                    for (int m = 0; m < 4; ++m)
#pragma unroll
                        for (int n = 0; n < 2; ++n) acc[a][b][m][n] = (f32x4){0.f, 0.f, 0.f, 0.f};
        }
        cur = nxt; cA = nA; cB = nB; ++ui;
        if constexpr (GATHER) {
#pragma unroll
            for (int h = 0; h < 2; ++h)
#pragma unroll
                for (int i = 0; i < 2; ++i) oA[h][i] = noA[h][i]; }
        if (wr == 1) PG_BAR;
    }
    PG_WAIT_V(0);
    PG_BAR;
    if constexpr (Epi::AFTER_DRAIN) E.fused(acc, cur, wr, wc, fr, fq, lds, wid, lane);
#undef PG_SA
#undef PG_SB
#undef PG_STAGE_A
#undef PG_STAGE_AH
#undef PG_GLDS
#undef PG_STAGE_B
#undef PG_LDA
#undef PG_LDB
#undef PG_MMA
#undef PG_CAT8
#undef PG_WAIT_V
#undef PG_WAIT_L
#undef PG_BAR
#undef PG_SCHED
#undef PG_GATHER_OFFS
}
}

struct MatDesc { const float* W0; const float* W1; const float* gain; bf16* WT; int K, N, ldw, mode; unsigned char* W8; };
__device__ __forceinline__ void p0_item(const MatDesc& d, float* scr, int item, int lane) {
    const int nblk = d.N / 64, kb = item / nblk, nb = item % nblk, k0 = 32 * kb, n0 = 64 * nb;
    const int c4 = lane & 15, kr = lane >> 4, n = n0 + 4 * c4;
    const float* col;
    if (d.mode == 1) { int src = n; if (n < 2 * DA) { const int seg = n >> 9, pl = (n >> 8) & 1, bj = (n >> 7) & 1, wc = (n >> 5) & 3, w = n & 31; src = seg * DA + (4 * pl + wc) * HD + 32 * bj + w; }
        else if (n >= 4 * DA) { const int np = n - 4 * DA, tile = np >> 8, c = np & 255; src = 4 * DA + (c >> 7) * DM + 128 * tile + (c & 127); }
        col = d.W0 + src; }
    else if (d.mode == 2) { const int hu = (n >> 8) * 128 + (n & 127); col = ((n >> 7) & 1) ? d.W1 + hu : d.W0 + hu; }
    else col = d.W0 + n;
    f32x4 v[8];
#pragma unroll
    for (int i = 0; i < 8; ++i) v[i] = *(const f32x4*)(col + (size_t)(k0 + 4 * i + kr) * d.ldw);
#pragma unroll
    for (int i = 0; i < 8; ++i) { const int kk = 4 * i + kr; const float g = d.gain ? d.gain[k0 + kk] : 1.0f; *(f32x4*)(scr + kk * 68 + 4 * c4) = v[i] * g; }
    asm volatile("s_waitcnt lgkmcnt(0)" ::: "memory");
    const int cq = lane & 3;
#pragma unroll
    for (int j = 0; j < 4; ++j) { const int nn = (lane >> 2) + 16 * j; const float* s = scr + (8 * cq) * 68 + nn;
        if ((d.mode == 1 && (n0 < 3 * DA || n0 >= 4 * DA)) || d.mode >= 2) {
            *(v2u*)((d.mode == 1 && n0 < 4 * DA ? (unsigned char*)d.WT : d.W8) + (size_t)(n0 + nn - (d.mode == 1 && n0 >= 4 * DA ? 4 * DA : 0)) * d.K + k0 + 8 * cq) = (v2u){pk4f8(s[0 * 68] * W8_SCALE, s[1 * 68] * W8_SCALE, s[2 * 68] * W8_SCALE, s[3 * 68] * W8_SCALE), pk4f8(s[4 * 68] * W8_SCALE, s[5 * 68] * W8_SCALE, s[6 * 68] * W8_SCALE, s[7 * 68] * W8_SCALE)}; }
        else { v4u o; o.x = pk2(s[0 * 68], s[1 * 68]); o.y = pk2(s[2 * 68], s[3 * 68]); o.z = pk2(s[4 * 68], s[5 * 68]); o.w = pk2(s[6 * 68], s[7 * 68]);
            *(v4u*)(d.WT + (size_t)(n0 + nn) * d.K + k0 + 8 * cq) = o; } }
    asm volatile("s_waitcnt lgkmcnt(0)" ::: "memory");
}
constexpr size_t OFF_WIN = 2 * MiB, OFF_WGLU = 10 * MiB, OFF_WA = 11 * MiB, OFF_WS = 12 * MiB, OFF_WOUT = 13 * MiB, OFF_WGU = 15 * MiB, OFF_WD = 31 * MiB, OFF_WSSM = 39 * MiB;
__device__ __forceinline__ void ph_weights(Frame& F, unsigned char* ws, bool first_part, int worker, int nworkers, int wv0 = 0, int nwv = NWAVES) {
    float* scr = (float*)(F.lds + F.wave * 16384);
    const int gw = worker * nwv + (F.wave - wv0), NGW = nworkers * nwv;
    constexpr int I_IN = (DM / 32) * (DIN / 64), I_GLU = (DS / 32) * (DS / 64), I_BR = (DA / 32) * (DM / 64), I_OUT = (DM / 32) * (DM / 64), I_GU = (DM / 32) * (512 / 64), I_D = (DEX / 32) * (DM / 64);
    constexpr int NITEMS = I_IN + I_GLU + 2 * I_BR + I_OUT + NEX * I_GU + NEX * I_D;
    for (int it = (first_part ? 0 : I_IN) + gw; it < (first_part ? I_IN : NITEMS); it += NGW) {
        int r = it; MatDesc d;
        if (r < I_IN) { d = MatDesc{F.w_in, nullptr, F.gain1, (bf16*)(ws + OFF_WIN), DM, DIN, DIN, 1, ws + OFF_W8}; }
        else if ((r -= I_IN) < I_GLU) { d = MatDesc{F.w_glu, nullptr, nullptr, (bf16*)(ws + OFF_WGLU), DS, DS, DS, 0}; }
        else if ((r -= I_GLU) < I_BR) { d = MatDesc{F.w_branch, nullptr, nullptr, (bf16*)(ws + OFF_WA), DA, DM, DM, 0}; }
        else if ((r -= I_BR) < I_BR) { d = MatDesc{F.w_branch + (size_t)DA * DM, nullptr, nullptr, (bf16*)(ws + OFF_WS), DS, DM, DM, 0}; }
        else if ((r -= I_BR) < I_OUT) { d = MatDesc{F.w_out, nullptr, nullptr, nullptr, DM, DM, DM, 3, ws + OFF_WOUT}; }
        else if ((r -= I_OUT) < NEX * I_GU) { const int e = r / I_GU; r %= I_GU;
            d = MatDesc{F.w_eg + (size_t)e * DM * DEX, F.w_eu + (size_t)e * DM * DEX, F.gain2, nullptr, DM, 512, DEX, 2, ws + OFF_WGU + (size_t)e * 512 * DM}; }
        else { r -= NEX * I_GU; const int e = r / I_D; r %= I_D;
            d = MatDesc{F.w_ed + (size_t)e * DEX * DM, nullptr, nullptr, (bf16*)(ws + OFF_WD) + (size_t)e * DM * DEX, DEX, DM, DM, 0}; }
        p0_item(d, scr, r, F.lane);
    }
}

struct SchedPlain {
    __device__ __forceinline__ void ready(const pg::Unit&) const {}
    pg::TileOrder o; const char* A; const char* B; int lda_b, ldb_b, nseg, khalf_b; size_t segA, segB;
    __device__ __forceinline__ bool next(int i, pg::Unit& u) const {
        const int ti = (nseg == 2) ? (i >> 1) : i, s = (nseg == 2) ? (i & 1) : 0; int pm, pn;
        if (!o.tile(ti, pm, pn)) return false;
        u.A = A + (size_t)pm * 256 * lda_b + s * segA; u.B = B + (size_t)pn * 256 * ldb_b + s * segB; u.list = nullptr; u.pm = pm; u.pn = pn; u.cnt = 256; u.aux = s;
        u.flags = (s == 0 ? pg::UF_FIRST : 0) | (s == nseg - 1 ? pg::UF_LAST : 0); return true;
    }
};
__device__ __forceinline__ float fast_sigmoid(float x) { return __builtin_amdgcn_rcpf(1.0f + __builtin_amdgcn_exp2f(-LOG2E * x)); }

struct EpiInproj {
    static constexpr bool PERM = true, AFTER_DRAIN = false;
    bf16 *Q, *K, *V, *U, *GT; const float *rstd, *q_gain, *k_gain, *b_gate; float ascale; int pn0;
    __device__ __forceinline__ void mid(pg::Acc&, const pg::Unit&, int, int, int, int) const {}
    __device__ __forceinline__ void operator()(pg::Acc& acc, const pg::Unit& u, int wr, int wc, int fr, int fq) const {
        const int row0 = u.pm * 256 + wr * 64 + fr, pn = u.pn + pn0;
        float rsv[2][4];
#pragma unroll
        for (int ai = 0; ai < 2; ++ai)
#pragma unroll
            for (int m = 0; m < 4; ++m) rsv[ai][m] = rstd[row0 + ai * 128 + m * 16] * ascale;
        if (pn < 4) {
            const bool isq = pn < 2; const float* gn = isq ? q_gain : k_gain; const float sc = isq ? QSCALE : 1.0f;
            bf16* base = (isq ? Q : K) + (4 * (pn & 1) + wc) * HD + 8 * fq;
            f32x4 gv[2][2];
#pragma unroll
            for (int bj = 0; bj < 2; ++bj)
#pragma unroll
                for (int n = 0; n < 2; ++n) gv[bj][n] = *(const f32x4*)(gn + 32 * bj + 8 * fq + 4 * n) * sc;
#pragma unroll
            for (int ai = 0; ai < 2; ++ai)
#pragma unroll
                for (int m = 0; m < 4; ++m) { const int row = row0 + ai * 128 + m * 16; const float rs = rsv[ai][m];
                    float s0 = 0.f, s1 = 0.f;
#pragma unroll
                    for (int bj = 0; bj < 2; ++bj)
#pragma unroll
                        for (int n = 0; n < 2; ++n) { const f32x4 t = acc[ai][bj][m][n]; s0 = __builtin_fmaf(t[0], t[0], s0); s1 = __builtin_fmaf(t[1], t[1], s1); s0 = __builtin_fmaf(t[2], t[2], s0); s1 = __builtin_fmaf(t[3], t[3], s1); }
                    float ss = s0 + s1; ss += __shfl_xor(ss, 16); ss += __shfl_xor(ss, 32);
                    const float r = rs / sqrtf(ss * (rs * rs * (1.0f / HD)) + EPS);
#pragma unroll
                    for (int bj = 0; bj < 2; ++bj) { const f32x4 a = acc[ai][bj][m][0] * (gv[bj][0] * r), b = acc[ai][bj][m][1] * (gv[bj][1] * r);
                        pg::u32x4 w; w.x = pg::cvt_pk_bf16(a[0], a[1]); w.y = pg::cvt_pk_bf16(a[2], a[3]); w.z = pg::cvt_pk_bf16(b[0], b[1]); w.w = pg::cvt_pk_bf16(b[2], b[3]);
                        *(pg::u32x4*)(base + (size_t)row * DA + 32 * bj) = w; } }
        } else if (pn < 8) {
            const bool isv = pn < 6;
#pragma unroll
            for (int ai = 0; ai < 2; ++ai)
#pragma unroll
                for (int m = 0; m < 4; ++m) { const int row = row0 + ai * 128 + m * 16; const float rs = rsv[ai][m];
#pragma unroll
                    for (int bj = 0; bj < 2; ++bj) { const f32x4 a = acc[ai][bj][m][0] * rs, b = acc[ai][bj][m][1] * rs;
                        pg::u32x4 w; w.x = pg::cvt_pk_bf16(a[0], a[1]); w.y = pg::cvt_pk_bf16(a[2], a[3]); w.z = pg::cvt_pk_bf16(b[0], b[1]); w.w = pg::cvt_pk_bf16(b[2], b[3]);
                        const int col = (pn & 1) * 256 + bj * 128 + wc * 32 + 8 * fq;
                        bf16* dst = isv ? V + (size_t)row * DA + col : U + ((size_t)(col >> 4) * T + row) * SGC + (col & 15);
                        *(pg::u32x4*)dst = w; } }
        }
    }
};
struct EpiGate {
    static constexpr bool PERM = true, AFTER_DRAIN = false;
    bf16* GT; const float *rstd, *b_gate;
    __device__ __forceinline__ void mid(pg::Acc&, const pg::Unit&, int, int, int, int) const {}
    __device__ __forceinline__ void operator()(pg::Acc& acc, const pg::Unit& u, int wr, int wc, int fr, int fq) const {
        const int row0 = u.pm * 256 + wr * 64 + fr, pn = u.pn + 8;
        float rsv[2][4];
#pragma unroll
        for (int ai = 0; ai < 2; ++ai)
#pragma unroll
            for (int m = 0; m < 4; ++m) rsv[ai][m] = rstd[row0 + ai * 128 + m * 16] * (1.0f / W8_SCALE);
            const int nm0 = (pn - 8) * 128 + 32 * wc + 8 * fq;
            f32x4 bv[2][2];
#pragma unroll
            for (int bj = 0; bj < 2; ++bj)
#pragma unroll
                for (int n = 0; n < 2; ++n) bv[bj][n] = *(const f32x4*)(b_gate + bj * DM + nm0 + 4 * n) * (-LOG2E);
            unsigned char* G8 = (unsigned char*)GT;
#pragma unroll
            for (int ai = 0; ai < 2; ++ai)
#pragma unroll
                for (int m = 0; m < 4; ++m) { const int row = row0 + ai * 128 + m * 16; const float rs = rsv[ai][m] * (-LOG2E); pg::u32x4 w;
#pragma unroll
                    for (int bj = 0; bj < 2; ++bj)
#pragma unroll
                        for (int n = 0; n < 2; ++n) { unsigned pk = 0u;
#pragma unroll
                            for (int h = 0; h < 2; ++h) { const pg::f32x2 ac = {acc[ai][bj][m][n][2 * h], acc[ai][bj][m][n][2 * h + 1]}, bb = {bv[bj][n][2 * h], bv[bj][n][2 * h + 1]};
                                const pg::f32x2 t = ac * rs + bb; pg::f32x2 e = {__builtin_amdgcn_exp2f(t[0]), __builtin_amdgcn_exp2f(t[1])}; e = e + 1.0f;
                                pg::f32x2 g = {__builtin_amdgcn_rcpf(e[0]), __builtin_amdgcn_rcpf(e[1])}; g = g * 255.0f + 0.5f;
                                const unsigned q0 = (unsigned)__builtin_fminf(__builtin_fmaxf(g[0], 1.0f), 255.0f), q1 = (unsigned)__builtin_fminf(__builtin_fmaxf(g[1], 1.0f), 255.0f);
                                pk |= (q0 << (16 * h)) | (q1 << (16 * h + 8)); }
                            w[2 * bj + n] = pk; }
                    *(pg::u32x4*)(G8 + (size_t)row * (2 * DM) + (size_t)(nm0 >> 3) * 16) = w; }

    }
};
__device__ __forceinline__ void unpack8(const pg::u32x4 w, f32x4& a, f32x4& b) { a = (f32x4){bflo(w.x), bfhi(w.x), bflo(w.y), bfhi(w.y)}; b = (f32x4){bflo(w.z), bfhi(w.z), bflo(w.w), bfhi(w.w)}; }
struct EpiGlu {
    static constexpr bool PERM = true, AFTER_DRAIN = false;
    const bf16* Z; bf16* YS; const float* b_glu;
    __device__ __forceinline__ void mid(pg::Acc&, const pg::Unit&, int, int, int, int) const {}
    __device__ __forceinline__ void operator()(pg::Acc& acc, const pg::Unit& u, int wr, int wc, int fr, int fq) const {
        const int row0 = u.pm * 256 + wr * 64 + fr, col0 = u.pn * 256 + wc * 32 + 8 * fq;
        f32x4 bv[2][2];
#pragma unroll
        for (int bj = 0; bj < 2; ++bj)
#pragma unroll
            for (int n = 0; n < 2; ++n) bv[bj][n] = *(const f32x4*)(b_glu + col0 + bj * 128 + 4 * n) * (-LOG2E);
#pragma unroll
        for (int ai = 0; ai < 2; ++ai)
#pragma unroll
            for (int m = 0; m < 4; ++m) { const size_t ro = (size_t)(row0 + ai * 128 + m * 16) * DS + col0;
#pragma unroll
                for (int bj = 0; bj < 2; ++bj) { f32x4 z0, z1; unpack8(*(const pg::u32x4*)(Z + ro + bj * 128), z0, z1);
                    f32x4 a, b;
#pragma unroll
                    for (int i = 0; i < 4; ++i) { a[i] = z0[i] * __builtin_amdgcn_rcpf(1.0f + __builtin_amdgcn_exp2f(__builtin_fmaf(acc[ai][bj][m][0][i], -LOG2E, bv[bj][0][i]))); b[i] = z1[i] * __builtin_amdgcn_rcpf(1.0f + __builtin_amdgcn_exp2f(__builtin_fmaf(acc[ai][bj][m][1][i], -LOG2E, bv[bj][1][i]))); }
                    pg::u32x4 w; w.x = pg::cvt_pk_bf16(a[0], a[1]); w.y = pg::cvt_pk_bf16(a[2], a[3]); w.z = pg::cvt_pk_bf16(b[0], b[1]); w.w = pg::cvt_pk_bf16(b[2], b[3]);
                    *(pg::u32x4*)(YS + ro + bj * 128) = w; } }
    }
};
__device__ __forceinline__ void unpack_u8x4(unsigned w, f32x4& o) { o = (f32x4){(float)(w & 255u), (float)((w >> 8) & 255u), (float)((w >> 16) & 255u), (float)(w >> 24)}; }
struct EpiBranch {
    static constexpr bool PERM = true, AFTER_DRAIN = false;
    const unsigned char* G8; bf16* MG;
    __device__ __forceinline__ void mid(pg::Acc& acc, const pg::Unit& u, int wr, int wc, int fr, int fq) const {
        const int row0 = u.pm * 256 + wr * 64 + fr, blk0 = u.pn * 32 + wc * 4 + fq;
#pragma unroll
        for (int ai = 0; ai < 2; ++ai) { pg::u32x4 g[4][2];
#pragma unroll
            for (int m = 0; m < 4; ++m)
#pragma unroll
                for (int bj = 0; bj < 2; ++bj) g[m][bj] = *(const pg::u32x4*)(G8 + (size_t)(row0 + ai * 128 + m * 16) * (2 * DM) + (size_t)(blk0 + 16 * bj) * 16);
#pragma unroll
            for (int m = 0; m < 4; ++m)
#pragma unroll
                for (int bj = 0; bj < 2; ++bj) { f32x4 a0, a1, b0, b1; unpack_u8x4(g[m][bj].x, a0); unpack_u8x4(g[m][bj].y, a1); unpack_u8x4(g[m][bj].z, b0); unpack_u8x4(g[m][bj].w, b1);
#pragma unroll
                    for (int i = 0; i < 4; ++i) { acc[ai][bj][m][0][i] *= a0[i] * __builtin_amdgcn_rcpf(b0[i]); acc[ai][bj][m][1][i] *= a1[i] * __builtin_amdgcn_rcpf(b1[i]); } } }
    }
    __device__ __forceinline__ void operator()(pg::Acc& acc, const pg::Unit& u, int wr, int wc, int fr, int fq) const {
        const int row0 = u.pm * 256 + wr * 64 + fr, col0 = u.pn * 256 + wc * 32 + 8 * fq, blk0 = u.pn * 32 + wc * 4 + fq;
#pragma unroll
        for (int ai = 0; ai < 2; ++ai) { pg::u32x2 g[4][2];
#pragma unroll
            for (int m = 0; m < 4; ++m)
#pragma unroll
                for (int bj = 0; bj < 2; ++bj) g[m][bj] = *(const pg::u32x2*)(G8 + (size_t)(row0 + ai * 128 + m * 16) * (2 * DM) + (size_t)(blk0 + 16 * bj) * 16 + 8);
#pragma unroll
            for (int m = 0; m < 4; ++m)
#pragma unroll
                for (int bj = 0; bj < 2; ++bj) { f32x4 g0, g1; unpack_u8x4(g[m][bj].x, g0); unpack_u8x4(g[m][bj].y, g1); const f32x4 a = acc[ai][bj][m][0] * g0 * (MG8_SCALE / 255.0f), b = acc[ai][bj][m][1] * g1 * (MG8_SCALE / 255.0f);
                    *(v2u*)((unsigned char*)MG + (size_t)(row0 + ai * 128 + m * 16) * DM + col0 + bj * 128) = (v2u){pk4f8(a[0], a[1], a[2], a[3]), pk4f8(b[0], b[1], b[2], b[3])}; } }
    }
};
struct EpiOut {
    static constexpr bool PERM = true, AFTER_DRAIN = false;
    bf16* XB; unsigned char* X8;
    __device__ __forceinline__ void mid(pg::Acc&, const pg::Unit&, int, int, int, int) const {}
    __device__ __forceinline__ void operator()(pg::Acc& acc, const pg::Unit& u, int wr, int wc, int fr, int fq) const {
        const int row0 = u.pm * 256 + wr * 64 + fr, col0 = u.pn * 256 + wc * 32 + 8 * fq;
        pg::u32x4 xv[2][4][2];
#pragma unroll
        for (int ai = 0; ai < 2; ++ai)
#pragma unroll
            for (int m = 0; m < 4; ++m)
#pragma unroll
                for (int bj = 0; bj < 2; ++bj) xv[ai][m][bj] = *(const pg::u32x4*)((const char*)XB + 2u * (unsigned)((row0 + ai * 128 + m * 16) * DM + col0 + bj * 128));
#pragma unroll
        for (int ai = 0; ai < 2; ++ai)
#pragma unroll
            for (int m = 0; m < 4; ++m)
#pragma unroll
                for (int bj = 0; bj < 2; ++bj) { f32x4 x0, x1; unpack8(xv[ai][m][bj], x0, x1); const f32x4 a = x0 + acc[ai][bj][m][0] * (1.0f / (W8_SCALE * MG8_SCALE)), b = x1 + acc[ai][bj][m][1] * (1.0f / (W8_SCALE * MG8_SCALE));
                    pg::u32x4 w; w.x = pg::cvt_pk_bf16(a[0], a[1]); w.y = pg::cvt_pk_bf16(a[2], a[3]); w.z = pg::cvt_pk_bf16(b[0], b[1]); w.w = pg::cvt_pk_bf16(b[2], b[3]);
                    const unsigned eo = (unsigned)((row0 + ai * 128 + m * 16) * DM + col0 + bj * 128);
                    *(pg::u32x4*)((char*)XB + 2u * eo) = w;
                    *(v2u*)(X8 + eo) = (v2u){pk4f8(a[0], a[1], a[2], a[3]), pk4f8(b[0], b[1], b[2], b[3])}; }
    }
};
constexpr int MOE_TAB_OFF = LDSCTL_OFF + 1024;
__device__ __forceinline__ void moe_build_tab(Frame& F) {
    LAS int* tab = (LAS int*)((LAS unsigned char*)F.lds + MOE_TAB_OFF);
    if (F.tid < 64) {
        const int c = F.tid; int cnt = 0;
        if (c < NCLS) cnt = (int)__hip_atomic_load(F.ctl + CW_CNT + 64 * c, __ATOMIC_RELAXED, __HIP_MEMORY_SCOPE_AGENT);
        int incl = (cnt + 255) >> 8;
#pragma unroll
        for (int d = 1; d < 32; d <<= 1) { const int o = __shfl_up(incl, d); if (c >= d) incl += o; }
        if (c < NCLS) { tab[32 + c] = cnt; tab[c] = incl - ((cnt + 255) >> 8); }
        if (c == NCLS - 1) tab[NCLS] = incl;
    }
    __syncthreads();
}
struct SchedMoe {
    const LAS int* tab; int G, c, nseg, mode; const char* A; const char* B; const int* LIST; unsigned* ctl; mutable unsigned pend;
    __device__ __forceinline__ void ready(const pg::Unit& u) const {
        if (mode == 1) { unsigned v = pend, sp = 0;
            while ((unsigned)__builtin_amdgcn_readfirstlane((int)v) < 4u) { __builtin_amdgcn_s_sleep(2); if (++sp > (1u << 20)) break; v = __hip_atomic_load(ctl + CW_TILE + 64 * u.pm, __ATOMIC_RELAXED, __HIP_MEMORY_SCOPE_AGENT); }
            asm volatile("" ::: "memory"); } }
    __device__ __forceinline__ int unit_index(int ti) const {
        const int nU = tab[NCLS] * 4, x = nU - 2 * G; int L = ti * G + c;
        if ((G & 3) == 0 && x > 0 && 3 * x <= G) { if (ti == 0) L = c; else if (ti == 1 && c >= x) L = G + (c - x); else if (ti == 2 && c >= G - 2 * x) L = G + x + c; else return -1; }
        return L < nU ? L : -1; }
    __device__ __forceinline__ bool next(int i, pg::Unit& u) const {
        const int ti = (nseg == 2) ? (i >> 1) : i, s = (nseg == 2) ? (i & 1) : 0;
        const int nT = tab[NCLS], nU = nT * 4; int L = ti * G + c;
        const int x = nU - 2 * G; const bool plan = (G & 3) == 0 && x > 0 && 3 * x <= G;
        if (plan) { const int n2 = G - 3 * x;
            if (mode == 0) { if (ti == 0) L = c; else if (ti == 1 && c >= x) L = G + (c - x); else if (ti == 2 && c >= G - 2 * x) L = G + x + c; else return false; }
            else { int p;
                if (c < x) { if (ti > 2) return false; p = (ti == 0 ? 0 : ti == 1 ? x + n2 : 4 * x + 2 * n2) + c; }
                else if (c < G - 2 * x) { if (ti > 1) return false; p = (ti == 0 ? x : 4 * x + n2) + (c - x); }
                else { if (ti > 1) return false; p = (ti == 0 ? 2 * x + n2 : 5 * x + 2 * n2) + (c - (G - 2 * x)); }
                if (p < x) L = p;
                else if (p < x + 2 * n2) { const int q = p - x; L = q < n2 ? x + q : G + (q - n2); }
                else { const int q = p - x - 2 * n2; L = q < 2 * x ? G - 2 * x + q : (q < 4 * x ? 2 * G - 3 * x + (q - 2 * x) : 2 * G - x + (q - 4 * x)); } } }
        if (L >= nU) return false;
        const int tileIdx = L >> 2, pn = L & 3; int cls = 0;
        { int hi_ = NCLS;
#pragma unroll 1
          while (hi_ - cls > 1) { const int mid_ = (cls + hi_) >> 1; if (tab[mid_] <= tileIdx) cls = mid_; else hi_ = mid_; } }
        const int tile = tileIdx - tab[cls]; int cnt = tab[32 + cls] - tile * 256; cnt = cnt > 256 ? 256 : cnt;
        const int grp = cls / 6; int lo, hi; pair_decode(cls % 6, lo, hi);
        u.list = LIST + (size_t)cls * T + tile * 256; u.cnt = cnt; u.pm = tileIdx; u.pn = pn;
        if (mode == 0) { const int e = grp * 4 + ((pn >> 1) ? hi : lo); u.A = A; u.B = B + ((size_t)e * 512 + (pn & 1) * 256) * DM; u.aux = pn >> 1; }
        else { u.A = A; u.B = B + ((size_t)(grp * 4 + lo) * DM + pn * 256) * (DEX * 2); u.aux = (hi - lo) * DM * DEX * 2;
            pend = __hip_atomic_load(ctl + CW_TILE + 64 * tileIdx, __ATOMIC_RELAXED, __HIP_MEMORY_SCOPE_AGENT); }
        u.flags = (s == 0 ? pg::UF_FIRST : 0) | (s == nseg - 1 ? pg::UF_LAST : 0); return true;
    }
};
struct EpiGateUp {
    static constexpr bool PERM = true, AFTER_DRAIN = false;
    bf16* HID; const float* rstd2; const float* tokw;
    __device__ __forceinline__ void mid(pg::Acc&, const pg::Unit&, int, int, int, int) const {}
    __device__ __forceinline__ void operator()(pg::Acc& acc, const pg::Unit& u, int wr, int wc, int fr, int fq) const {
        const int slot = u.aux, hcol = slot * DEX + (u.pn & 1) * 128 + 32 * wc + 8 * fq;
#pragma unroll
        for (int ai = 0; ai < 2; ++ai) { int tok[4]; float rs[4], ww[4];
#pragma unroll
            for (int m = 0; m < 4; ++m) { const int r = ai * 128 + wr * 64 + m * 16 + fr; tok[m] = u.list[r < u.cnt ? r : 0]; }
#pragma unroll
            for (int m = 0; m < 4; ++m) { rs[m] = rstd2[tok[m]]; ww[m] = tokw[2 * tok[m] + slot]; }
#pragma unroll
            for (int m = 0; m < 4; ++m) { const int r = ai * 128 + wr * 64 + m * 16 + fr;
                if (r < u.cnt) { pg::u32x4 o;
#pragma unroll
                    for (int n = 0; n < 2; ++n) { const f32x4 ga = acc[ai][0][m][n], gu = ga * acc[ai][1][m][n]; const float rl = rs[m] * (-LOG2E / W8_SCALE), cw = rs[m] * rs[m] * ww[m] * (1.0f / (W8_SCALE * W8_SCALE)); f32x4 h;
#pragma unroll
                        for (int i = 0; i < 4; ++i) h[i] = gu[i] * cw * __builtin_amdgcn_rcpf(1.0f + __builtin_amdgcn_exp2f(ga[i] * rl));
                        o[2 * n] = pg::cvt_pk_bf16(h[0], h[1]); o[2 * n + 1] = pg::cvt_pk_bf16(h[2], h[3]); }
                    *(pg::u32x4*)(HID + (size_t)tok[m] * 512 + hcol) = o; } } }
    }
};
struct EpiDown {
    static constexpr bool PERM = true, AFTER_DRAIN = false;
    float* out; const bf16* XB;
    __device__ __forceinline__ void mid(pg::Acc&, const pg::Unit&, int, int, int, int) const {}
    __device__ __forceinline__ void operator()(pg::Acc& acc, const pg::Unit& u, int wr, int wc, int fr, int fq) const {
        const int col0 = u.pn * 256 + wc * 32 + 8 * fq;
        int tok[2][4];
#pragma unroll
        for (int ai = 0; ai < 2; ++ai)
#pragma unroll
            for (int m = 0; m < 4; ++m) { const int r = ai * 128 + wr * 64 + m * 16 + fr; tok[ai][m] = u.list[r < u.cnt ? r : 0]; }
        pg::u32x4 xb[2][4][2];
#pragma unroll
        for (int ai = 0; ai < 2; ++ai)
#pragma unroll
            for (int m = 0; m < 4; ++m)
#pragma unroll
                for (int bj = 0; bj < 2; ++bj) xb[ai][m][bj] = *(const pg::u32x4*)(XB + (size_t)tok[ai][m] * DM + col0 + bj * 128);
#pragma unroll
        for (int ai = 0; ai < 2; ++ai)
#pragma unroll
            for (int m = 0; m < 4; ++m) { const int r = ai * 128 + wr * 64 + m * 16 + fr;
                if (r < u.cnt) {
#pragma unroll
                    for (int bj = 0; bj < 2; ++bj) { f32x4 x0, x1; unpack8(xb[ai][m][bj], x0, x1); float* o = out + (size_t)tok[ai][m] * DM + col0 + bj * 128;
                        *(f32x4*)o = x0 + acc[ai][bj][m][0]; *(f32x4*)(o + 4) = x1 + acc[ai][bj][m][1]; } } }
    }
};
namespace att {
typedef short bf16x8 __attribute__((ext_vector_type(8)));
typedef short s16x4 __attribute__((ext_vector_type(4)));
typedef float f32x16 __attribute__((ext_vector_type(16)));
typedef short v4i16_t __attribute__((ext_vector_type(4)));
constexpr int SLOTB = 8192, K_OFF = 0, V_OFF = 6 * SLOTB, NBT = 576, BIAS_OFF = 12 * SLOTB, WS_OFF = BIAS_OFF + 2 * NBT * 4, OST_OFF = WS_OFF + 2048;
__device__ __forceinline__ int crow(int r, int hi) { return (r & 3) + 8 * (r >> 2) + 4 * hi; }
__device__ __forceinline__ s16x4 vtr(const LAS unsigned char* p) { return __builtin_bit_cast(s16x4, __builtin_amdgcn_ds_read_tr16_b64_v4i16((LAS v4i16_t*)p)); }
#define ATT_MX3(a, b, c) __builtin_fmaxf(__builtin_fmaxf((a), (b)), (c))
__device__ __forceinline__ float rowmax(const f32x16& p0, const f32x16& p1) {
    float a = ATT_MX3(p0[0], p0[1], p1[0]), b = ATT_MX3(p0[2], p0[3], p1[1]); a = ATT_MX3(a, p1[2], p1[3]);
#pragma unroll
    for (int r = 4; r < 16; r += 4) { a = ATT_MX3(a, p0[r], p0[r + 1]); b = ATT_MX3(b, p0[r + 2], p0[r + 3]); a = ATT_MX3(a, p1[r], p1[r + 1]); b = ATT_MX3(b, p1[r + 2], p1[r + 3]); }
    float m = __builtin_fmaxf(a, b); auto rr = __builtin_amdgcn_permlane32_swap(__float_as_uint(m), __float_as_uint(m), false, false);
    return __builtin_fmaxf(__uint_as_float(rr[0]), __uint_as_float(rr[1])); }
__device__ __forceinline__ void glds16(const void* sbase, unsigned voff, unsigned lds_base) {
    unsigned sv; asm volatile("s_mov_b32 %0, m0\n\ts_mov_b32 m0, %3\n\ts_nop 0\n\tglobal_load_lds_dwordx4 %1, %2\n\ts_mov_b32 m0, %0" : "=&s"(sv) : "v"(voff), "s"(sbase), "s"(lds_base) : "memory"); }
#define ATT_SBAR() __builtin_amdgcn_sched_barrier(0)
#define ATT_PIN(x) asm volatile("" : "+v"(x))
#define ATT_MFMA(a, b, c) __builtin_amdgcn_mfma_f32_32x32x16_bf16(a, b, c, 0, 0, 0)
#define ATT_WAIT_BAR(N) asm volatile("s_waitcnt vmcnt(" #N ") lgkmcnt(0)\n\ts_barrier" ::: "memory")

__device__ __forceinline__ void att_decode(int q, int& st, int& cp) { if (q < 96) { st = q / 12; cp = 15 - (q - 12 * st); } else { const int r = q - 96; cp = 3 - (r >> 3); st = r & 7; } }
struct AttCarry { bf16x8 qr[4]; int s0; bool pre; };
__device__ __forceinline__ int attn_unit(Frame& F, int x, int q, bool fill, AttCarry& C, unsigned nq, volatile LAS int* qslot) {
    int st_, cp; att_decode(q, st_, cp); const int pr_ = x + 8 * st_, b = pr_ >> 2, hp = pr_ & 3;
    LAS unsigned char* L = (LAS unsigned char*)F.lds;
    const int tid = F.tid, lane = F.lane, r32 = lane & 31, hi = lane >> 5, wid = F.wave;
    const int hh = wid >> 2, h = 2 * hp + hh, qb = wid & 3, ci = qb >> 1, qh = qb & 1, c0 = 2 * cp;
    const int trow = b * SEQ + (c0 + ci) * CHK + qh * 32;
    const LAS float* biasL = (const LAS float*)(L + BIAS_OFF) + hh * NBT;
    LAS float* wsf = (LAS float*)(L + WS_OFF) + wid * 64;
    if (fill) {
    int tid_ = tid; asm volatile("" : "+v"(tid_));
    for (int idx = tid_; idx < 2 * NBT; idx += NTHR) { const int hd = idx / NBT, e = 447 - idx % NBT;
        ((LAS float*)(L + BIAS_OFF))[idx] = e < 0 ? -30000.f : F.rel_bias[(2 * hp + hd) * NREL + (e < NREL ? e : NREL - 1)] * LOG2E; } }
    const int j0 = c0 >= LEFT ? 0 : LEFT - c0, NT = 10 - j0;
    const long krow0 = (long)b * SEQ + (long)(c0 - LEFT + j0) * CHK;
    const bf16* kbase = F.K + (2 * hp) * HD + (krow0 + 8 * wid) * DA; const bf16* vbase = F.V + (2 * hp) * HD + (wid >> 2) * 32 + (krow0 + 16 * (wid & 3)) * DA;
    const unsigned kvo = (unsigned)(((((lane & 7) ^ (lane >> 3)) << 3) + (lane >> 3) * DA) * 2), vvo = (unsigned)(((lane & 3) * 8 + (lane >> 2) * DA) * 2);
    const unsigned lds0 = (unsigned)(__UINTPTR_TYPE__)L, kdst = lds0 + K_OFF + wid * 1024, vdst = lds0 + V_OFF + wid * 1024;
#define ATT_DMA_K(t, slot) do { const bf16* s_ = kbase + (long)(t) * CHK * DA; glds16(s_, kvo, (unsigned)__builtin_amdgcn_readfirstlane(kdst + (slot))); glds16(s_ + HD, kvo, (unsigned)__builtin_amdgcn_readfirstlane(kdst + 3 * SLOTB + (slot))); } while (0)
#define ATT_DMA_V(t, slot) do { const bf16* s_ = vbase + (long)(t) * CHK * DA; glds16(s_, vvo, (unsigned)__builtin_amdgcn_readfirstlane(vdst + (slot))); glds16(s_ + HD, vvo, (unsigned)__builtin_amdgcn_readfirstlane(vdst + 3 * SLOTB + (slot))); } while (0)
    const LAS unsigned char* vp0 = L + V_OFF + hh * 3 * SLOTB + ((lane >> 4) & 1) * 32 + (lane & 3) * 8 + (4 * hi + ((lane & 15) >> 2)) * 64;
    const LAS unsigned char* kp0 = L + K_OFF + hh * 3 * SLOTB + r32 * 128;
    const int kx = (hi ^ (r32 & 7)) << 4;
#define ATT_RNX(sl) (((sl) == 2 * SLOTB) ? 0 : (sl) + SLOTB)
    bf16x8 qr[4]; const bool pre = C.pre; const int s0 = pre ? C.s0 : 0;
    if (!pre) { ATT_DMA_K(0, s0); ATT_DMA_V(0, s0); ATT_DMA_K(1, ATT_RNX(s0));
#pragma unroll
        for (int d0 = 0; d0 < 4; ++d0) qr[d0] = *(const bf16x8*)(F.Q + (size_t)(trow + r32) * DA + h * HD + d0 * 16 + hi * 8); }
    else {
#pragma unroll
        for (int d0 = 0; d0 < 4; ++d0) qr[d0] = C.qr[d0]; }
    float mhat = 0.f, l_reg = 0.f; f32x16 o[2]; bool mz = true;
#pragma unroll
    for (int r = 0; r < 16; ++r) { o[0][r] = 0.f; o[1][r] = 0.f; }
    const int qi = qh * 32 + r32; bool resc = false;
    f32x16 pA0, pA1, pB0, pB1; bf16x8 kf[8]; s16x4 vlo[8], vhi[8]; pg::u32x4 pw0, pw1, pw2, pw3;
    int sl_prev = s0, sl_cur = s0, sl_next = ATT_RNX(s0);
#define ATT_ROT() do { sl_prev = sl_cur; sl_cur = sl_next; sl_next = (sl_next == 2 * SLOTB) ? 0 : sl_next + SLOTB; } while (0)
#define ATT_KLOAD2(kp, d0) do { const int ko_ = kx ^ (32 * (d0)); kf[2 * (d0)] = *(const LAS bf16x8*)((kp) + ko_); kf[2 * (d0) + 1] = *(const LAS bf16x8*)((kp) + 4096 + ko_); } while (0)
#define ATT_CBASE(t) const int dc_ = ci + LEFT - j0 - (t); const bool cf_ = dc_ < 0 || dc_ >= 5; const float cv_ = (dc_ < 0 || dc_ > LEFT) ? -30000.f : bfar; \
        const LAS float* bp_ = biasL + (384 - 64 * (dc_ & 7)) - qi + 4 * hi
#define ATT_CLD(X, OFFS, lo, hi_) do { if (cf_) { _Pragma("unroll") for (int r = (lo); r < (hi_); ++r) X[r] = cv_; } else { _Pragma("unroll") for (int r = (lo); r < (hi_); ++r) X[r] = bp_[(OFFS) + ((r & 3) + 8 * (r >> 2))]; } } while (0)
#define ATT_CSUB(X0, X1) do { _Pragma("unroll") for (int r = 0; r < 16; ++r) { X0[r] -= mhat; X1[r] -= mhat; } } while (0)
#define ATT_EX(v) __builtin_amdgcn_exp2f(v)
#define ATT_DECIDE(C0, C1) do { const float rm = rowmax(C0, C1); resc = false; \
        if (__builtin_expect(__any(rm > 8.0f), 0)) { const float dl = __builtin_fmaxf(rm, 0.f), f = __builtin_amdgcn_exp2f(-dl); mhat += dl; l_reg *= f; if (hi == 0) wsf[r32] = f; resc = true; mz = false; \
            _Pragma("unroll") for (int r = 0; r < 16; ++r) { C0[r] -= dl; C1[r] -= dl; } } } while (0)
#define ATT_RESC() do { if (resc) { _Pragma("unroll") for (int d_ = 0; d_ < 2; ++d_) _Pragma("unroll") for (int r = 0; r < 16; ++r) o[d_][r] *= wsf[crow(r, hi)]; } } while (0)
    if (pre) { ATT_WAIT_BAR(4); }
    else if (NT > 2) { ATT_DMA_K(2, ATT_RNX(ATT_RNX(s0))); ATT_WAIT_BAR(6); } else ATT_WAIT_BAR(4);
    const float bfar = biasL[0];
    { ATT_CBASE(0); ATT_CLD(pA0, 0, 0, 16); ATT_CLD(pA1, 32, 0, 16); }
#pragma unroll
    for (int d0 = 0; d0 < 4; ++d0) ATT_KLOAD2(kp0 + sl_cur, d0);
#pragma unroll
    for (int d0 = 0; d0 < 4; ++d0) { pA0 = ATT_MFMA(kf[2 * d0], qr[d0], pA0); pA1 = ATT_MFMA(kf[2 * d0 + 1], qr[d0], pA1); }
    ATT_DECIDE(pA0, pA1); ATT_RESC();
#pragma unroll
    for (int r = 0; r < 16; ++r) { pA0[r] = ATT_EX(pA0[r]); pA1[r] = ATT_EX(pA1[r]); }
    if (tid == 0) *qslot = (int)nq;
    ATT_WAIT_BAR(0);
    if (NT > 3) ATT_DMA_K(3, sl_cur);
    ATT_DMA_V(1, sl_next); ATT_ROT();
#pragma unroll
    for (int d0 = 0; d0 < 4; ++d0) ATT_KLOAD2(kp0 + sl_cur, d0);
    { ATT_CBASE(1); ATT_CLD(pB0, 0, 0, 16); ATT_CLD(pB1, 32, 0, 16); if (!mz) ATT_CSUB(pB0, pB1); }
    if (NT > 3) { ATT_WAIT_BAR(4); } else { ATT_WAIT_BAR(0); }
#define ATT_PKW(P, i) pg::cvt_pk_bf16(P[i], P[(i) + 1])
#define ATT_PAF(k) __builtin_bit_cast(bf16x8, pw##k)
#define ATT_VFR(i) (bf16x8){vlo[i][0], vlo[i][1], vlo[i][2], vlo[i][3], vhi[i][0], vhi[i][1], vhi[i][2], vhi[i][3]}
#define ATT_VRD(i) do { vlo[i] = vtr(vp_ + (((i) >> 2) * 4096 + ((i) & 3) * 1024)); vhi[i] = vtr(vp_ + (((i) >> 2) * 4096 + ((i) & 3) * 1024 + 512)); } while (0)
#define ATT_KRD(G, d0) do { if (G) { ATT_KLOAD2(kp0 + sl_next, d0); ATT_SBAR(); } } while (0)
#define ATT_GAPA(MF, a0, a1, a2, a3, W0, W1, PW) do { MF; sacc += a0; sacc += a1; sacc += a2; sacc += a3; W0; W1; ATT_PIN(PW); ATT_PIN(sacc); ATT_SBAR(); } while (0)
#define ATT_GAPB(MF, X, i) do { MF; X[i] = ATT_EX(X[i]); X[(i) + 1] = ATT_EX(X[(i) + 1]); X[(i) + 2] = ATT_EX(X[(i) + 2]); X[(i) + 3] = ATT_EX(X[(i) + 3]); ATT_PIN(X); ATT_SBAR(); } while (0)
#define ATT_STEP(C0, C1, P0, P1, t, GK, GV, GL) do { ATT_SBAR(); \
    const LAS unsigned char* vp_ = vp0 + sl_prev; \
    float sacc = P0[0] + P0[1]; \
                            ATT_GAPA(C0 = ATT_MFMA(kf[0], qr[0], C0), P0[2], P0[3], P0[4], P0[5],     pw0[0] = ATT_PKW(P0, 0),  pw0[1] = ATT_PKW(P0, 2),  pw0); \
                            ATT_GAPA(C1 = ATT_MFMA(kf[1], qr[0], C1), P0[6], P0[7], P0[8], P0[9],     pw0[2] = ATT_PKW(P0, 4),  pw0[3] = ATT_PKW(P0, 6),  pw0); \
                            ATT_GAPA(C0 = ATT_MFMA(kf[2], qr[1], C0), P0[10], P0[11], P0[12], P0[13], pw1[0] = ATT_PKW(P0, 8),  pw1[1] = ATT_PKW(P0, 10), pw1); \
                            ATT_GAPA(C1 = ATT_MFMA(kf[3], qr[1], C1), P0[14], P0[15], P1[0], P1[1],   pw1[2] = ATT_PKW(P0, 12), pw1[3] = ATT_PKW(P0, 14), pw1); \
    ATT_VRD(0); ATT_SBAR(); ATT_GAPA(C0 = ATT_MFMA(kf[4], qr[2], C0), P1[2], P1[3], P1[4], P1[5],     pw2[0] = ATT_PKW(P1, 0),  pw2[1] = ATT_PKW(P1, 2),  pw2); \
    ATT_VRD(4); ATT_SBAR(); ATT_GAPA(C1 = ATT_MFMA(kf[5], qr[2], C1), P1[6], P1[7], P1[8], P1[9],     pw2[2] = ATT_PKW(P1, 4),  pw2[3] = ATT_PKW(P1, 6),  pw2); \
    ATT_VRD(1); ATT_SBAR(); ATT_GAPA(C0 = ATT_MFMA(kf[6], qr[3], C0), P1[10], P1[11], P1[12], P1[13], pw3[0] = ATT_PKW(P1, 8),  pw3[1] = ATT_PKW(P1, 10), pw3); \
    ATT_VRD(5); ATT_SBAR(); ATT_GAPA(C1 = ATT_MFMA(kf[7], qr[3], C1), P1[14], P1[15], 0.f, 0.f,       pw3[2] = ATT_PKW(P1, 12), pw3[3] = ATT_PKW(P1, 14), pw3); \
    l_reg += sacc; \
    if (GK) ATT_DMA_K((t) + 3, sl_cur); if (GV) ATT_DMA_V((t) + 1, sl_next); \
    ATT_DECIDE(C0, C1); \
    ATT_CBASE((t) + 1); ATT_SBAR(); \
    ATT_VRD(2); if (GL) ATT_CLD(P0, 0, 0, 8);  ATT_SBAR(); ATT_GAPB(o[0] = ATT_MFMA(ATT_PAF(0), ATT_VFR(0), o[0]), C0, 0); \
    ATT_VRD(6); if (GL) ATT_CLD(P0, 0, 8, 16); ATT_SBAR(); ATT_GAPB(o[1] = ATT_MFMA(ATT_PAF(0), ATT_VFR(4), o[1]), C0, 4); \
    ATT_VRD(3); if (GL) ATT_CLD(P1, 32, 0, 8);  ATT_SBAR(); ATT_GAPB(o[0] = ATT_MFMA(ATT_PAF(1), ATT_VFR(1), o[0]), C0, 8); \
    ATT_VRD(7); if (GL) ATT_CLD(P1, 32, 8, 16); ATT_SBAR(); ATT_GAPB(o[1] = ATT_MFMA(ATT_PAF(1), ATT_VFR(5), o[1]), C0, 12); \
    ATT_KRD(GL, 0); ATT_GAPB(o[0] = ATT_MFMA(ATT_PAF(2), ATT_VFR(2), o[0]), C1, 0); \
    ATT_KRD(GL, 1); ATT_GAPB(o[1] = ATT_MFMA(ATT_PAF(2), ATT_VFR(6), o[1]), C1, 4); \
    ATT_KRD(GL, 2); ATT_GAPB(o[0] = ATT_MFMA(ATT_PAF(3), ATT_VFR(3), o[0]), C1, 8); \
    ATT_KRD(GL, 3); ATT_GAPB(o[1] = ATT_MFMA(ATT_PAF(3), ATT_VFR(7), o[1]), C1, 12); \
    if (GL) { if (!mz) ATT_CSUB(P0, P1); ATT_PIN(P0); ATT_PIN(P1); } \
    } while (0)
#define ATT_ENDW(tt) do { if ((tt) + 3 < NT) { ATT_WAIT_BAR(4); } else if ((tt) + 2 < NT) { ATT_WAIT_BAR(2); } else { ATT_WAIT_BAR(0); } } while (0)
    { int t = 1;
#pragma unroll 1
      for (; t + 1 < NT; t += 2) {
          ATT_STEP(pB0, pB1, pA0, pA1, t, (t + 3 < NT), (t + 1 < NT), (t + 1 < NT));     ATT_ENDW(t);     ATT_RESC(); ATT_ROT();
          ATT_STEP(pA0, pA1, pB0, pB1, t + 1, (t + 4 < NT), (t + 2 < NT), (t + 2 < NT)); ATT_ENDW(t + 1); ATT_RESC(); ATT_ROT();
      }
      ATT_STEP(pB0, pB1, pA0, pA1, NT - 1, false, false, false); ATT_RESC(); }
    const int qn = *qslot;
    if (qn < 128) { int stn, cpn; att_decode(qn, stn, cpn); const int pn_ = x + 8 * stn, bn = pn_ >> 2, hpn = pn_ & 3, c0n = 2 * cpn, j0n = c0n >= LEFT ? 0 : LEFT - c0n;
        const long krn = (long)bn * SEQ + (long)(c0n - LEFT + j0n) * CHK;
        const bf16* kbn = F.K + (2 * hpn) * HD + (krn + 8 * wid) * DA; const bf16* vbn = F.V + (2 * hpn) * HD + (wid >> 2) * 32 + (krn + 16 * (wid & 3)) * DA;
        const int n0 = sl_next, n1 = ATT_RNX(n0), n2 = ATT_RNX(n1);
#define ATT_DMA_N(base, vo, dst, t, slot) do { const bf16* s_ = (base) + (long)(t) * CHK * DA; glds16(s_, vo, (unsigned)__builtin_amdgcn_readfirstlane((dst) + (slot))); glds16(s_ + HD, vo, (unsigned)__builtin_amdgcn_readfirstlane((dst) + 3 * SLOTB + (slot))); } while (0)
        ATT_DMA_N(kbn, kvo, kdst, 0, n0); ATT_DMA_N(vbn, vvo, vdst, 0, n0); ATT_DMA_N(kbn, kvo, kdst, 1, n1);
        { const int trn = bn * SEQ + (c0n + ci) * CHK + qh * 32;
#pragma unroll
          for (int d0 = 0; d0 < 4; ++d0) C.qr[d0] = *(const bf16x8*)(F.Q + (size_t)(trn + r32) * DA + (2 * hpn + hh) * HD + d0 * 16 + hi * 8); }
        if (j0n < 8) ATT_DMA_N(kbn, kvo, kdst, 2, n2);
#undef ATT_DMA_N
        C.pre = true; C.s0 = n0; }
    else C.pre = false;
    { float sacc = pB0[0] + pB0[1];
#pragma unroll
      for (int r = 2; r < 16; ++r) sacc += pB0[r];
#pragma unroll
      for (int r = 0; r < 16; ++r) sacc += pB1[r];
      l_reg += sacc;
      pw0 = (pg::u32x4){ATT_PKW(pB0, 0), ATT_PKW(pB0, 2), ATT_PKW(pB0, 4), ATT_PKW(pB0, 6)}; pw1 = (pg::u32x4){ATT_PKW(pB0, 8), ATT_PKW(pB0, 10), ATT_PKW(pB0, 12), ATT_PKW(pB0, 14)};
      pw2 = (pg::u32x4){ATT_PKW(pB1, 0), ATT_PKW(pB1, 2), ATT_PKW(pB1, 4), ATT_PKW(pB1, 6)}; pw3 = (pg::u32x4){ATT_PKW(pB1, 8), ATT_PKW(pB1, 10), ATT_PKW(pB1, 12), ATT_PKW(pB1, 14)};
      const LAS unsigned char* vp_ = vp0 + sl_cur;
#pragma unroll
      for (int i = 0; i < 8; ++i) ATT_VRD(i);
      o[0] = ATT_MFMA(ATT_PAF(0), ATT_VFR(0), o[0]); o[1] = ATT_MFMA(ATT_PAF(0), ATT_VFR(4), o[1]); o[0] = ATT_MFMA(ATT_PAF(1), ATT_VFR(1), o[0]); o[1] = ATT_MFMA(ATT_PAF(1), ATT_VFR(5), o[1]);
      o[0] = ATT_MFMA(ATT_PAF(2), ATT_VFR(2), o[0]); o[1] = ATT_MFMA(ATT_PAF(2), ATT_VFR(6), o[1]); o[0] = ATT_MFMA(ATT_PAF(3), ATT_VFR(3), o[0]); o[1] = ATT_MFMA(ATT_PAF(3), ATT_VFR(7), o[1]); }
    { auto rr = __builtin_amdgcn_permlane32_swap(__float_as_uint(l_reg), __float_as_uint(l_reg), false, false); l_reg = __uint_as_float(rr[0]) + __uint_as_float(rr[1]); }
    int ln_ = lane; asm volatile("" : "+v"(ln_));
    const int er32 = ln_ & 31, ehi = ln_ >> 5;
    LAS float* wse = (LAS float*)(L + WS_OFF) + wid * 64 + 32;
    if (ehi == 0) wse[er32] = 1.0f / l_reg;
    asm volatile("s_waitcnt lgkmcnt(0)" ::: "memory");
    LAS bf16* stg = (LAS bf16*)(L + OST_OFF) + wid * 1024; LAS bf16* stl = stg + 4 * ehi * 32 + er32; const LAS float* wsl = wse + 4 * ehi;
    bf16* Ow = F.YA + (size_t)(b * SEQ + (c0 + ci) * CHK + qh * 32 + (ln_ >> 2)) * DA + h * HD + (ln_ & 3) * 8; const LAS bf16* stq = stg + (ln_ >> 2) * 32 + (ln_ & 3) * 8;
#pragma unroll
    for (int d_ = 0; d_ < 2; ++d_) {
#pragma unroll
        for (int r = 0; r < 16; ++r) { const int ro = (r & 3) + 8 * (r >> 2); stl[ro * 32] = (bf16)f2bf(o[d_][r] * wsl[ro]); }
        asm volatile("s_waitcnt lgkmcnt(0)" ::: "memory");
#pragma unroll
        for (int i = 0; i < 2; ++i) { const v4u v = *(const LAS v4u*)(stq + i * 512); *(v4u*)(Ow + (size_t)i * 16 * DA + d_ * 32) = v; }
        asm volatile("s_waitcnt lgkmcnt(0)" ::: "memory"); }
    return qn;
#undef ATT_DMA_K
#undef ATT_DMA_V
#undef ATT_ROT
#undef ATT_KLOAD2
#undef ATT_CBASE
#undef ATT_CLD
#undef ATT_CSUB
#undef ATT_EX
#undef ATT_DECIDE
#undef ATT_RESC
#undef ATT_PKW
#undef ATT_PAF
#undef ATT_VFR
#undef ATT_VRD
#undef ATT_KRD
#undef ATT_GAPA
#undef ATT_GAPB
#undef ATT_STEP
#undef ATT_ENDW
}
__device__ __forceinline__ void attn_phase(Frame& F) {
    volatile LAS int* qslot = (volatile LAS int*)((LAS unsigned char*)F.lds + LDSCTL_OFF + 2048);
    const int x0 = (int)(xb_xcc_id() & 7u); int last_hp = -1;
#pragma unroll 1
    for (int round = 0;; ++round) {
        int x = x0;
        if (round > 0) {
            if (F.tid < 8) qslot[4 + F.tid] = (int)__hip_atomic_load(F.ctl + CW_ATTQ + 64 * F.tid, __ATOMIC_RELAXED, __HIP_MEMORY_SCOPE_AGENT);
            __syncthreads();
            x = -1;
#pragma unroll 1
            for (int xi = 7; xi >= 0; --xi) { const int xx = (x0 + xi) & 7; if (qslot[4 + xx] < 128) x = xx; }
            __syncthreads();
            if (x < 0) break; }
        if (F.tid == 0) *qslot = (int)xb_add(F.ctl + CW_ATTQ + 64 * x, 1u);
        __syncthreads();
        int q = *qslot;
        __syncthreads();
        AttCarry C; C.pre = false; C.s0 = 0;
#pragma unroll 1
        while (q < 128) {
            unsigned nq = 0u; if (F.tid == 0) nq = xb_add(F.ctl + CW_ATTQ + 64 * x, 1u);
            int st_, cp_; att_decode(q, st_, cp_); const int hp = (x + 8 * st_) & 3;
            q = attn_unit(F, x, q, hp != last_hp, C, nq, qslot); last_hp = hp;
        }
        __syncthreads(); }
}
#undef ATT_WAIT_BAR
#undef ATT_SBAR
#undef ATT_PIN
#undef ATT_MFMA
#undef ATT_MX3
}

constexpr size_t OFF_SLOC = 384 * MiB, OFF_SIN = 400 * MiB;
constexpr size_t TAB_A = 0, TAB_A32 = 16 * 1024, TAB_A64 = 32 * 1024, TAB_BB = 64 * 1024, TAB_CM = 256 * 1024;
typedef float f32x2v __attribute__((ext_vector_type(2)));
struct SsmCoef { float lre, lim, step, a_re, a_im, f_re, f_im; };
__device__ __forceinline__ SsmCoef ssm_coef(const Frame& F, int g, int p) {
    SsmCoef c; c.lre = F.lam_re[g * NST + p]; c.lim = F.lam_im[g * NST + p]; c.step = expf(F.log_step[g]);
    const float mag = expf(c.lre * c.step), ang = c.lim * c.step; c.a_re = mag * cosf(ang); c.a_im = mag * sinf(ang);
    const float nr = c.a_re - 1.0f, ni = c.a_im, den = c.lre * c.lre + c.lim * c.lim;
    c.f_re = (nr * c.lre + ni * c.lim) / den; c.f_im = (ni * c.lre - nr * c.lim) / den; return c;
}
__device__ __forceinline__ f32x2v ssm_apow(const SsmCoef& c, int n) { const float mag = expf((float)n * c.lre * c.step), ang = (float)n * (c.lim * c.step); return (f32x2v){mag * cosf(ang), mag * sinf(ang)}; }
__device__ __forceinline__ void ph_ssmtab(Frame& F, unsigned char* ws, int thr0) {
    unsigned char* tab = ws + OFF_TAB;
    const int gt = F.vcu * (NTHR - thr0) + (F.tid - thr0), NT_ = F.G * (NTHR - thr0);
    for (int idx = gt; idx < NGR * NST; idx += NT_) { const int g = idx / NST, p = idx % NST; const SsmCoef c = ssm_coef(F, g, p);
        ((f32x2v*)(tab + TAB_A))[idx] = (f32x2v){c.a_re, c.a_im}; ((f32x2v*)(tab + TAB_A32))[idx] = ssm_apow(c, 32); ((f32x2v*)(tab + TAB_A64))[idx] = ssm_apow(c, 64); }
    for (int idx = gt; idx < NGR * 4 * 64; idx += NT_) { const int lane = idx & 63, st = (idx >> 6) & 3, g = idx >> 8, p = 32 * (st >> 1) + (lane & 31), part = st & 1;
        const SsmCoef c = ssm_coef(F, g, p); unsigned w[4];
#pragma unroll
        for (int j = 0; j < 8; j += 2) { float v[2];
#pragma unroll
            for (int q = 0; q < 2; ++q) { const int ch = 8 * (lane >> 5) + j + q; const float br = F.sb_re[(g * NST + p) * SGC + ch], bi = F.sb_im[(g * NST + p) * SGC + ch]; v[q] = part ? (c.f_re * bi + c.f_im * br) : (c.f_re * br - c.f_im * bi); }
            w[j >> 1] = pk2(v[0], v[1]); }
        ((v4u*)(tab + TAB_BB))[idx] = (v4u){w[0], w[1], w[2], w[3]}; }
    for (int idx = gt; idx < NGR * 5 * 64; idx += NT_) { const int lane = idx & 63, ks = (idx >> 6) % 5, g = idx / 320, col = lane & 15; unsigned w[4];
#pragma unroll
        for (int j = 0; j < 8; j += 2) { float v[2];
#pragma unroll
            for (int q = 0; q < 2; ++q) { const int k = 8 * (lane >> 4) + j + q + 32 * ks;
                if (ks < 4) { const int p = k >> 1; v[q] = (k & 1) ? -F.sc_im[(g * SGC + col) * NST + p] : F.sc_re[(g * SGC + col) * NST + p]; }
                else { const int kk = k - 128; v[q] = (kk == col) ? F.ssm_d[g * SGC + col] : 0.f; } }
            w[j >> 1] = pk2(v[0], v[1]); }
        ((v4u*)(tab + TAB_CM))[idx] = (v4u){w[0], w[1], w[2], w[3]}; }
    bf16* W = (bf16*)(ws + OFF_WSSM);
    for (int idx = gt; idx < NGR * 256 * 8; idx += NT_) { const int jb = idx & 7, n = (idx >> 3) & 255, g = idx >> 11, p = (n & 127) >> 1, part = n & 1, e0 = ((n >> 7) ? 24 : 56) - 8 * jb;
        v4u* dst = (v4u*)(W + ((size_t)(g * 256 + n)) * 1024 + jb * 128);
        if (e0 < 0) {
#pragma unroll
            for (int q = 0; q < 16; ++q) dst[q] = (v4u){0u, 0u, 0u, 0u}; }
        else { const SsmCoef c = ssm_coef(F, g, p); const f32x2v pw = ssm_apow(c, e0); float gr = pw.x * c.f_re - pw.y * c.f_im, gi = pw.x * c.f_im + pw.y * c.f_re;
            float br[SGC], bi[SGC];
#pragma unroll
            for (int ch = 0; ch < SGC; ++ch) { br[ch] = F.sb_re[(g * NST + p) * SGC + ch]; bi[ch] = F.sb_im[(g * NST + p) * SGC + ch]; }
#pragma unroll
            for (int sI = 0; sI < 8; ++sI) { const int j = 7 - sI; unsigned w[8];
#pragma unroll
                for (int q = 0; q < 8; ++q) { const float v0 = part ? (gr * bi[2 * q] + gi * br[2 * q]) : (gr * br[2 * q] - gi * bi[2 * q]), v1 = part ? (gr * bi[2 * q + 1] + gi * br[2 * q + 1]) : (gr * br[2 * q + 1] - gi * bi[2 * q + 1]); w[q] = pk2(v0, v1); }
                dst[2 * j] = (v4u){w[0], w[1], w[2], w[3]}; dst[2 * j + 1] = (v4u){w[4], w[5], w[6], w[7]};
                const float ngr = gr * c.a_re - gi * c.a_im, ngi = gr * c.a_im + gi * c.a_re; gr = ngr; gi = ngi; } }
    }
}
struct SchedSloc {
    __device__ __forceinline__ void ready(const pg::Unit&) const {}
    const char* U; const char* W; int c;
    __device__ __forceinline__ bool next(int i, pg::Unit& u) const {
        if (i != 0 || c >= NGR * 2) return false;
        const int g = c >> 1, mt = c & 1;
        u.A = U + ((size_t)g * T * SGC + (size_t)mt * 256 * 1024) * 2; u.B = W + (size_t)g * 256 * 1024 * 2; u.list = nullptr; u.pm = mt; u.pn = 0; u.cnt = 256; u.aux = g; u.flags = pg::UF_FIRST | pg::UF_LAST; return true;
    }
};
struct EpiSloc {
    static constexpr bool PERM = false, AFTER_DRAIN = true;
    float* SIN; const f32x2v* A32; const f32x2v* A64;
    __device__ __forceinline__ void mid(pg::Acc&, const pg::Unit&, int, int, int, int) const {}
    __device__ __forceinline__ void operator()(pg::Acc&, const pg::Unit&, int, int, int, int) const {}
    __device__ __forceinline__ void fused(pg::Acc& acc, const pg::Unit& u, int wr, int wc, int fr, int fq, LAS unsigned char* lds, int wid, int lane) const {
        LAS float* Lf = (LAS float*)lds;
        const int g = u.aux, tid = wid * 64 + lane, bl = tid >> 6, p = tid & 63, b = u.pm * 8 + bl;
        f32x2v sin[NCH];
#pragma unroll
        for (int half = 0; half < 2; ++half) {
#pragma unroll
            for (int ai = 0; ai < 2; ++ai)
#pragma unroll
                for (int m = 0; m < 4; ++m)
#pragma unroll
                    for (int n = 0; n < 2; ++n) { const int row = ai * 128 + wr * 64 + m * 16 + fr; *(LAS f32x4*)(Lf + row * 128 + (((8 * wc + 4 * n + fq) ^ (row & 31)) << 2)) = acc[ai][half][m][n]; }
            __syncthreads();
            float* sp = SIN + ((((size_t)b * NCH) * NGR + g) * 2 + half) * 128 + 2 * p;
            if (half == 0) { const f32x2v a = A64[g * NST + p]; f32x2v s = (f32x2v){0.f, 0.f};
#pragma unroll
                for (int c = 0; c < NCH; ++c) { sin[c] = s; *(f32x2v*)(sp + (size_t)c * NGR * 256) = s;
                    const f32x2v loc = *(const LAS f32x2v*)(Lf + (bl * 32 + c) * 128 + ((((p >> 1) ^ c) << 2) | ((2 * p) & 3))); s = (f32x2v){a.x * s.x - a.y * s.y + loc.x, a.x * s.y + a.y * s.x + loc.y}; } }
            else { const f32x2v a = A32[g * NST + p];
#pragma unroll
                for (int c = 0; c < NCH; ++c) { const f32x2v s = sin[c];
                    const f32x2v loc = *(const LAS f32x2v*)(Lf + (bl * 32 + c) * 128 + ((((p >> 1) ^ c) << 2) | ((2 * p) & 3))); *(f32x2v*)(sp + (size_t)c * NGR * 256) = (f32x2v){a.x * s.x - a.y * s.y + loc.x, a.x * s.y + a.y * s.x + loc.y}; } }
            __syncthreads();
        }
    }
};
namespace ssm {
typedef short bf16x8 __attribute__((ext_vector_type(8)));
typedef float f32x16 __attribute__((ext_vector_type(16)));
constexpr int SST_OFF = 0, ZT_OFF = 65536;
__device__ __forceinline__ float gelu_fast(float x) { return x * fast_sigmoid(1.5957691216057308f * (x + 0.044715f * x * x * x)); }
__device__ __forceinline__ void ssm_unit(Frame& F, const unsigned char* tab, const float* SIN, int b, int c) {
    LAS unsigned char* L = (LAS unsigned char*)F.lds;
    const int lane = F.lane, wid = F.wave, cc = lane & 31, h = lane >> 5, t0 = b * SEQ + c * CHK;
    LAS unsigned char* sst = L + SST_OFF + wid * 8192;
    LAS bf16* ZT = (LAS bf16*)(L + ZT_OFF);
    struct GPre { f32x2v aA, aB, sA, sB; bf16x8 Bb[4], Au[2]; };
    auto gload = [&](int g, GPre& P) {
        P.aA = ((const f32x2v*)(tab + TAB_A))[g * NST + cc]; P.aB = ((const f32x2v*)(tab + TAB_A))[g * NST + 32 + cc];
#pragma unroll
        for (int st = 0; st < 4; ++st) P.Bb[st] = ((const bf16x8*)(tab + TAB_BB))[(g * 4 + st) * 64 + lane];
        const bf16* ub = F.U + ((size_t)g * T + t0) * SGC;
#pragma unroll
        for (int pt = 0; pt < 2; ++pt) { const int i = lane & 31, pos = 32 * ((i >> 2) & 1) + 16 * pt + (i & 3) + 4 * (i >> 3); P.Au[pt] = *(const bf16x8*)(ub + pos * SGC + 8 * (lane >> 5)); }
        const float* sinp = SIN + ((((size_t)b * NCH + c) * NGR + g) * 2 + h) * 128;
        P.sA = *(const f32x2v*)(sinp + 2 * cc); P.sB = *(const f32x2v*)(sinp + 2 * (32 + cc));
    };
    GPre cur; gload(wid * 4, cur);
#pragma unroll 1
    for (int gi = 0; gi < 4; ++gi) {
        const int g = wid * 4 + gi;
        GPre nxt; gload(wid * 4 + (gi < 3 ? gi + 1 : gi), nxt);
        const f32x2v aA = cur.aA, aB = cur.aB;
        bf16x8 Cm[5];
#pragma unroll
        for (int ks = 0; ks < 5; ++ks) Cm[ks] = ((const bf16x8*)(tab + TAB_CM))[(g * 5 + ks) * 64 + lane];
        const bf16* ubase = F.U + ((size_t)g * T + t0) * SGC;
        bf16x8 A5v[2][2];
#pragma unroll
        for (int pt = 0; pt < 2; ++pt)
#pragma unroll
            for (int rb = 0; rb < 2; ++rb) { A5v[pt][rb] = (bf16x8){0, 0, 0, 0, 0, 0, 0, 0}; if ((lane >> 4) < 2) A5v[pt][rb] = *(const bf16x8*)(ubase + (32 * rb + 16 * pt + (lane & 15)) * SGC + 8 * (lane >> 4)); }
        f32x16 bu[2][4];
#pragma unroll
        for (int pt = 0; pt < 2; ++pt) {
#pragma unroll
            for (int st = 0; st < 4; ++st) { f32x16 z;
#pragma unroll
                for (int r = 0; r < 16; ++r) z[r] = 0.f;
                bu[pt][st] = __builtin_amdgcn_mfma_f32_32x32x16_bf16(cur.Au[pt], cur.Bb[st], z, 0, 0, 0); } }
        f32x2v sA = cur.sA, sB = cur.sB;
#pragma unroll
        for (int pt = 0; pt < 2; ++pt) {
#pragma unroll
            for (int r = 0; r < 16; ++r) {
                { const float re = __builtin_fmaf(aA.x, sA.x, __builtin_fmaf(-aA.y, sA.y, bu[pt][0][r])), im = __builtin_fmaf(aA.x, sA.y, __builtin_fmaf(aA.y, sA.x, bu[pt][1][r])); sA.x = re; sA.y = im; }
                { const float re = __builtin_fmaf(aB.x, sB.x, __builtin_fmaf(-aB.y, sB.y, bu[pt][2][r])), im = __builtin_fmaf(aB.x, sB.y, __builtin_fmaf(aB.y, sB.x, bu[pt][3][r])); sB.x = re; sB.y = im; }
                const int R = 16 * h + r;
                *(LAS unsigned*)(sst + R * 256 + ((((cc >> 2) ^ r) << 2) | (cc & 3)) * 4) = pg::cvt_pk_bf16(sA.x, sA.y);
                *(LAS unsigned*)(sst + R * 256 + ((((8 + (cc >> 2)) ^ r) << 2) | (cc & 3)) * 4) = pg::cvt_pk_bf16(sB.x, sB.y);
            }
#pragma unroll
            for (int rb = 0; rb < 2; ++rb) { const int Rr = 16 * rb + (lane & 15); f32x4 y = (f32x4){0.f, 0.f, 0.f, 0.f};
#pragma unroll
                for (int ks = 0; ks < 4; ++ks) { const bf16x8 As = *(const LAS bf16x8*)(sst + Rr * 256 + ((((lane >> 4) + 4 * ks) ^ (lane & 15)) << 4));
                    y = __builtin_amdgcn_mfma_f32_16x16x32_bf16(As, Cm[ks], y, 0, 0, 0); }
                y = __builtin_amdgcn_mfma_f32_16x16x32_bf16(A5v[pt][rb], Cm[4], y, 0, 0, 0);
#pragma unroll
                for (int i = 0; i < 4; ++i) { const int pos = 32 * rb + 16 * pt + 4 * (lane >> 4) + i; ZT[pos * DS + g * SGC + (lane & 15)] = (bf16)f2bf(gelu_fast(y[i])); }
            }
        }
        cur = nxt;
    }
    __syncthreads();
#pragma unroll
    for (int i = 0; i < 8; ++i) { const int idx = F.tid + NTHR * i, row = idx >> 6, c16 = idx & 63; *(v4u*)(F.Z + (size_t)(t0 + row) * DS + c16 * 8) = *(const LAS v4u*)(ZT + row * DS + c16 * 8); }
    __syncthreads();
}
__device__ __forceinline__ void ssm_phase(Frame& F, const unsigned char* ws) {
#pragma unroll 1
    for (int u = F.vcu; u < NB * NCH; u += F.G) ssm_unit(F, ws + OFF_TAB, (const float*)(ws + OFF_SIN), u / NCH, u % NCH);
}
}

namespace rt {
typedef float f32x16 __attribute__((ext_vector_type(16)));
constexpr int WT_OFF = 0, LG_OFF = 81920, SS_OFF = 114688, HIST_OFF = 115712, BASE_OFF = 115840;
__device__ __forceinline__ void route_stage(Frame& F, int t0, int nt) {
    LAS unsigned char* L = (LAS unsigned char*)F.lds; LAS bf16* Wh = (LAS bf16*)(L + WT_OFF); LAS bf16* Wl = Wh + 20 * DM;
    if (F.vcu * 128 >= T) return;
    for (int k = t0; k < DM; k += nt) { const float g = F.gain2[k]; const f32x4 a = *(const f32x4*)(F.w_gr + k * 4);
        const f32x4 e0 = *(const f32x4*)(F.w_er + k * 16), e1 = *(const f32x4*)(F.w_er + k * 16 + 4), e2 = *(const f32x4*)(F.w_er + k * 16 + 8), e3 = *(const f32x4*)(F.w_er + k * 16 + 12);
#pragma unroll
        for (int o = 0; o < 4; ++o) { const float w5[5] = {a[o] * g, e0[o] * g, e1[o] * g, e2[o] * g, e3[o] * g};
#pragma unroll
            for (int q = 0; q < 5; ++q) { const int oo = 4 * q + o; const unsigned hb = f2bf(w5[q]); Wh[oo * DM + k] = (bf16)hb; Wl[oo * DM + k] = (bf16)f2bf(w5[q] - bf2f(hb)); } } }
}
__device__ __forceinline__ void route_phase(Frame& F, bool staged) {
    LAS unsigned char* L = (LAS unsigned char*)F.lds;
    LAS bf16* Wh = (LAS bf16*)(L + WT_OFF);
    LAS bf16* Wl = Wh + 20 * DM;
    LAS float* LG = (LAS float*)(L + LG_OFF);
    LAS float* SS = (LAS float*)(L + SS_OFF);
    LAS unsigned* hist = (LAS unsigned*)(L + HIST_OFF); LAS unsigned* base = (LAS unsigned*)(L + BASE_OFF);
    const int tid = F.tid, lane = F.lane, wid = F.wave;
    if (F.vcu * 128 >= T) return;
    if (!staged) route_stage(F, tid, NTHR);
    if (tid < 32) hist[tid] = 0u;
    __syncthreads();
    const int tb = wid >> 1, kh = wid & 1, i = lane & 31, h = lane >> 5;
#pragma unroll 1
    for (int it = F.vcu; it * 128 < T; it += F.G) {
        const int t0 = it * 128;
        { const bf16* xp = F.XB + (size_t)(t0 + 32 * tb + i) * DM + 512 * kh + 8 * h;
          const LAS bf16* whp = Wh + (i < 20 ? i : 0) * DM + 512 * kh + 8 * h; const LAS bf16* wlp = Wl + (i < 20 ? i : 0) * DM + 512 * kh + 8 * h;
          f32x16 acc;
#pragma unroll
          for (int r = 0; r < 16; ++r) acc[r] = 0.f;
          float ss = 0.f;
#pragma unroll
          for (int qb = 0; qb < 32; qb += 16) { pg::u32x4 xv[16];
#pragma unroll
              for (int j = 0; j < 16; ++j) xv[j] = *(const pg::u32x4*)(xp + 16 * (qb + j));
#pragma unroll
              for (int j = 0; j < 16; ++j) { const int q = qb + j; const pg::u32x4 xw = xv[j]; f32x4 x0, x1; unpack8(xw, x0, x1);
                  ss += ((x0[0] * x0[0] + x0[1] * x0[1]) + (x0[2] * x0[2] + x0[3] * x0[3])) + ((x1[0] * x1[0] + x1[1] * x1[1]) + (x1[2] * x1[2] + x1[3] * x1[3]));
                  const pg::bf16x8 xa = __builtin_bit_cast(pg::bf16x8, xw), bh = *(const LAS pg::bf16x8*)(whp + 16 * q), bl = *(const LAS pg::bf16x8*)(wlp + 16 * q);
                  acc = __builtin_amdgcn_mfma_f32_32x32x16_bf16(xa, bh, acc, 0, 0, 0); acc = __builtin_amdgcn_mfma_f32_32x32x16_bf16(xa, bl, acc, 0, 0, 0); } }
          ss += __shfl_xor(ss, 32);
          if (h == 0) SS[(32 * tb + i) * 2 + kh] = ss;
#pragma unroll
          for (int r = 0; r < 16; ++r) { const int row = (r & 3) + 8 * (r >> 2) + 4 * h; LG[((32 * tb + row) * 2 + kh) * 32 + i] = acc[r]; } }
        __syncthreads();
        int cls = 0; unsigned lrank = 0; float wlo = 0.f, whi = 0.f, rs = 0.f;
        if (tid < 128) {
            float lg[20];
#pragma unroll
            for (int o = 0; o < 20; ++o) lg[o] = LG[(tid * 2) * 32 + o] + LG[(tid * 2 + 1) * 32 + o];
            rs = 1.0f / sqrtf((SS[tid * 2] + SS[tid * 2 + 1]) * (1.0f / DM) + EPS);
            float g4[4]; int gi = 0;
#pragma unroll
            for (int j = 0; j < 4; ++j) g4[j] = lg[j] * rs + F.b_gr[j];
#pragma unroll
            for (int j = 1; j < 4; ++j) if (g4[j] > g4[gi]) gi = j;
            float gs = 0.f;
#pragma unroll
            for (int j = 0; j < 4; ++j) gs += expf(g4[j] - g4[gi]);
            const float gp = 1.0f / gs;
            float le[4];
#pragma unroll
            for (int j = 0; j < 4; ++j) { float a = 0.f;
#pragma unroll
                for (int q = 0; q < 4; ++q) a = (gi == q) ? lg[4 + 4 * q + j] : a;
                le[j] = a * rs + F.b_er[gi * 4 + j]; }
            int e1 = 0;
#pragma unroll
            for (int j = 1; j < 4; ++j) if (le[j] > le[e1]) e1 = j;
            int e2 = (e1 == 0) ? 1 : 0;
#pragma unroll
            for (int j = 0; j < 4; ++j) if (j != e1 && le[j] > le[e2]) e2 = j;
            const float p2 = expf(le[e2] - le[e1]);
            const float w1 = gp / (1.0f + p2), w2 = gp * p2 / (1.0f + p2);
            const int lo = e1 < e2 ? e1 : e2, hi2 = e1 < e2 ? e2 : e1;
            wlo = e1 < e2 ? w1 : w2; whi = e1 < e2 ? w2 : w1;
            cls = gi * 6 + pair_index(lo, hi2);
            lrank = __hip_atomic_fetch_add(hist + cls, 1u, __ATOMIC_RELAXED, __HIP_MEMORY_SCOPE_WORKGROUP);
        }
        __syncthreads();
        if (tid < NCLS) { const unsigned n = hist[tid]; base[tid] = n ? xb_add(F.ctl + CW_CNT + 64 * tid, n) : 0u; hist[tid] = 0u; }
        __syncthreads();
        if (tid < 128) { const int t = t0 + tid; const unsigned rank = base[cls] + lrank;
            F.LIST[(size_t)cls * T + rank] = t; F.TOKC[t] = cls; F.TOKW[2 * t] = wlo; F.TOKW[2 * t + 1] = whi; F.RSTD2[t] = rs; }
        __syncthreads();
    }
}
}

__global__ void __launch_bounds__(NTHR, 2) mk_fwd(Args args) {
    extern __shared__ __attribute__((aligned(16))) unsigned char lds[];
    Frame F;
    F.lds = lds; F.tid = threadIdx.x; F.lane = F.tid & 63; F.wave = __builtin_amdgcn_readfirstlane(F.tid >> 6);
    F.G = gridDim.x; { const int bx = blockIdx.x; F.vcu = (F.G % 8 == 0) ? (bx % 8) * (F.G / 8) + bx / 8 : bx; }
    unsigned char* ws = args.ws;
    F.x = args.in[0]; F.gain1 = args.in[1]; F.w_in = args.in[2]; F.b_gate = args.in[3]; F.q_gain = args.in[4]; F.k_gain = args.in[5]; F.rel_bias = args.in[6];
    F.lam_re = args.in[7]; F.lam_im = args.in[8]; F.log_step = args.in[9]; F.sb_re = args.in[10]; F.sb_im = args.in[11]; F.sc_re = args.in[12]; F.sc_im = args.in[13];
    F.ssm_d = args.in[14]; F.w_glu = args.in[15]; F.b_glu = args.in[16]; F.w_branch = args.in[17]; F.w_out = args.in[18]; F.gain2 = args.in[19];
    F.w_gr = args.in[20]; F.b_gr = args.in[21]; F.w_er = args.in[22]; F.b_er = args.in[23]; F.w_eg = args.in[24]; F.w_eu = args.in[25]; F.w_ed = args.in[26];
    F.out = args.out; F.ctl = (unsigned*)(ws + OFF_CTL);
    F.XB8 = ws + OFF_XB8; F.XB = (bf16*)(ws + OFF_XB); F.Q = (bf16*)(ws + OFF_Q); F.K = (bf16*)(ws + OFF_K); F.V = (bf16*)(ws + OFF_V); F.U = (bf16*)(ws + OFF_U); F.GT = (bf16*)(ws + OFF_G);
    F.YA = (bf16*)(ws + OFF_YA); F.Z = (bf16*)(ws + OFF_Z); F.YS = (bf16*)(ws + OFF_YS); F.MG = (bf16*)(ws + OFF_MERGED); F.HID = (bf16*)(ws + OFF_HID);
    F.LIST = (int*)(ws + OFF_LIST); F.TOKC = (int*)(ws + OFF_TOKC); F.TOKW = (float*)(ws + OFF_TOKW); F.RSTD1 = (float*)(ws + OFF_RSTD1); F.RSTD2 = (float*)(ws + OFF_RSTD2);
    for (int u = F.tid; u < (LDS_BYTES - LDSCTL_OFF) / 4; u += NTHR) ((LAS unsigned*)((LAS unsigned char*)lds + LDSCTL_OFF))[u] = 0u;
    __syncthreads();
    XcdBarrier bar = xcd_barrier_post(F.ctl + CW_BAR, (volatile LAS unsigned*)((LAS unsigned char*)lds + MISC_OFF) + 8);
    const int lo = args.ph_lo, hi = args.ph_hi;
#define IN(k) (lo <= (k) && (k) < hi)
#define SEAM(k) do { if (IN(k) && IN((k) + 1)) xcd_barrier(bar); } while (0)
    if (IN(0)) {
    if (F.wave < 4) ph_xconv(F, 4);
    else { ph_weights(F, ws, true, F.vcu, F.G, 4, 4); ph_ssmtab(F, ws, 256); }
    }
    SEAM(0);
    if (IN(1)) {
    { SchedPlain S; S.o.init(T, 3 * DA, F.G, (int)blockIdx.x); S.A = (const char*)F.XB8; S.B = (const char*)(ws + OFF_WIN); S.lda_b = DM; S.ldb_b = DM; S.nseg = 1; S.segA = 0; S.segB = 0; S.khalf_b = DM / 2;
      EpiInproj E{F.Q, F.K, F.V, F.U, F.GT, F.RSTD1, F.q_gain, F.k_gain, F.b_gate, 1.0f / W8_SCALE, 0};
      pg::gemm_phase<EpiInproj, SchedPlain, false, false, true>((LAS unsigned char*)lds, DM / 2, DM, DM, S, E); }
    { SchedPlain S; S.o.init(T, DS, F.G, (int)blockIdx.x); S.A = (const char*)F.XB; S.B = (const char*)(ws + OFF_WIN) + (size_t)3 * DA * DM * 2; S.lda_b = DM * 2; S.ldb_b = DM * 2; S.nseg = 1; S.segA = 0; S.segB = 0; S.khalf_b = DM;
      EpiInproj E{F.Q, F.K, F.V, F.U, F.GT, F.RSTD1, F.q_gain, F.k_gain, F.b_gate, 1.0f, 6};
      pg::gemm_phase<EpiInproj, SchedPlain, false>((LAS unsigned char*)lds, DM, DM * 2, DM * 2, S, E); }
    { SchedPlain S; S.o.init(T, 2 * DM, F.G, (int)blockIdx.x); S.A = (const char*)F.XB8; S.B = (const char*)(ws + OFF_W8); S.lda_b = DM; S.ldb_b = DM; S.nseg = 1; S.segA = 0; S.segB = 0; S.khalf_b = DM / 2;
      EpiGate E{F.GT, F.RSTD1, F.b_gate};
      pg::gemm_phase<EpiGate, SchedPlain, false, false, true>((LAS unsigned char*)lds, DM / 2, DM, DM, S, E); }
    }
    SEAM(1);
    if (IN(2)) {
    { SchedSloc S; S.U = (const char*)F.U; S.W = (const char*)(ws + OFF_WSSM); S.c = (int)blockIdx.x;
      EpiSloc E{(float*)(ws + OFF_SIN), (const f32x2v*)(ws + OFF_TAB + TAB_A32), (const f32x2v*)(ws + OFF_TAB + TAB_A64)};
      pg::gemm_phase<EpiSloc, SchedSloc, false>((LAS unsigned char*)lds, 1024, 2048, 2048, S, E);
      __syncthreads(); }
    att::attn_phase(F);
    ph_weights(F, ws, false, F.vcu, F.G); __syncthreads();
    }
    SEAM(2);
    if (IN(3)) {
    ssm::ssm_phase(F, ws);
    }
    SEAM(3);
    if (IN(4)) {
    { SchedPlain S; S.o.init(T, DS, F.G, (int)blockIdx.x); S.A = (const char*)F.Z; S.B = (const char*)(ws + OFF_WGLU); S.lda_b = DS * 2; S.ldb_b = DS * 2; S.nseg = 1; S.segA = 0; S.segB = 0; S.khalf_b = DS;
      EpiGlu E{F.Z, F.YS, F.b_glu};
      pg::gemm_phase<EpiGlu, SchedPlain, false>((LAS unsigned char*)lds, DS, DS * 2, DS * 2, S, E); }
    }
    SEAM(4);
    if (IN(5)) {
    { SchedPlain S; S.o.init(T, DM, F.G, (int)blockIdx.x); S.A = (const char*)F.YA; S.B = (const char*)(ws + OFF_WA); S.lda_b = DA * 2; S.ldb_b = DA * 2; S.nseg = 2; S.khalf_b = DA;
      S.segA = (size_t)((const char*)F.YS - (const char*)F.YA); S.segB = OFF_WS - OFF_WA;
      EpiBranch E{(const unsigned char*)F.GT, F.MG};
      pg::gemm_phase<EpiBranch, SchedPlain, false>((LAS unsigned char*)lds, DA, DA * 2, DA * 2, S, E); }
    }
    SEAM(5);
    if (IN(6)) {
    { SchedPlain S; S.o.init(T, DM, F.G, (int)blockIdx.x); S.A = (const char*)F.MG; S.B = (const char*)(ws + OFF_WOUT); S.lda_b = DM; S.ldb_b = DM; S.nseg = 1; S.segA = 0; S.segB = 0; S.khalf_b = DM / 2;
      EpiOut E{F.XB, F.XB8};
      pg::gemm_phase<EpiOut, SchedPlain, false, false, true>((LAS unsigned char*)lds, DM / 2, DM, DM, S, E); }
    }
    const bool rstaged = IN(6) && IN(7);
    if (rstaged) xcd_barrier_w(bar, [&] { rt::route_stage(F, F.tid - 64, NTHR - 64); });
    if (IN(7)) {
    rt::route_phase(F, rstaged);
    }
    SEAM(7);
    if (IN(8)) {
    { moe_build_tab(F);
      SchedMoe S; S.tab = (const LAS int*)((LAS unsigned char*)lds + MOE_TAB_OFF); S.G = F.G; S.c = F.vcu; S.nseg = 1; S.mode = 0; S.A = (const char*)F.XB8; S.B = (const char*)(ws + OFF_WGU); S.LIST = F.LIST; S.ctl = F.ctl;
      EpiGateUp E{F.HID, F.RSTD2, F.TOKW};
      pg::gemm_phase<EpiGateUp, SchedMoe, true, false, true>((LAS unsigned char*)lds, DM / 2, DM, DM, S, E);
      __syncthreads();
      if (F.tid == 0) { __builtin_amdgcn_fence(__ATOMIC_RELEASE, "agent"); asm volatile("s_waitcnt vmcnt(0)" ::: "memory");
          for (int i = 0; i < 8; ++i) { const int L = S.unit_index(i); if (L >= 0) __hip_atomic_fetch_add(F.ctl + CW_TILE + 64 * (L >> 2), 1u, __ATOMIC_RELAXED, __HIP_MEMORY_SCOPE_AGENT); } } }
    }
    if (IN(9)) {
    { moe_build_tab(F);
      SchedMoe S; S.tab = (const LAS int*)((LAS unsigned char*)lds + MOE_TAB_OFF); S.G = F.G; S.c = F.vcu; S.nseg = 1; S.mode = 1; S.A = (const char*)F.HID; S.B = (const char*)(ws + OFF_WD); S.LIST = F.LIST; S.ctl = F.ctl;
      EpiDown E{F.out, F.XB};
      pg::gemm_phase<EpiDown, SchedMoe, true, true>((LAS unsigned char*)lds, 2 * DEX, 512 * 2, DEX * 2, S, E); }
    }
#undef IN
#undef SEAM
}

extern "C" void kernel_launch(void* const* d_in, const int* in_sizes, int n_in, void* d_out, int out_size, void* d_ws, size_t ws_size, hipStream_t stream) {
    static int grid = 0;
    if (grid == 0) {
        if (n_in != 27 || in_sizes[0] != T * DM || out_size != T * DM || ws_size < WS_END) { fprintf(stderr, "kernel_launch: unexpected shapes (n_in %d, in0 %d, out %d, ws %zu)\n", n_in, n_in > 0 ? in_sizes[0] : -1, out_size, ws_size); grid = -1; return; }
        int dev = 0, cus = 0;
        if (hipGetDevice(&dev) != hipSuccess || hipDeviceGetAttribute(&cus, hipDeviceAttributeMultiprocessorCount, dev) != hipSuccess) { grid = -1; return; }
        if (hipFuncSetAttribute((const void*)mk_fwd, hipFuncAttributeMaxDynamicSharedMemorySize, LDS_BYTES) != hipSuccess) { fprintf(stderr, "kernel_launch: hipFuncSetAttribute failed\n"); grid = -1; return; }
        int per_cu = 0;
        if (hipOccupancyMaxActiveBlocksPerMultiprocessor(&per_cu, (const void*)mk_fwd, NTHR, LDS_BYTES) != hipSuccess || per_cu < 1) fprintf(stderr, "kernel_launch: occupancy query reports %d\n", per_cu);
        (void)hipGetLastError();
        grid = cus;
    }
    if (grid < 0) return;
    (void)hipMemsetAsync((char*)d_ws + OFF_CTL, 0, CTL_ZERO_BYTES, stream);
    Args a{};
    for (int i = 0; i < 27; ++i) a.in[i] = (const float*)d_in[i];
    a.out = (float*)d_out; a.ws = (unsigned char*)d_ws; a.ph_lo = 0; a.ph_hi = 10;
    hipLaunchKernelGGL(mk_fwd, dim3(grid), dim3(NTHR), LDS_BYTES, stream, a);
}
```
